# Optimizing an MI355X kernel written in HIP

```python
import math
import jax, jax.numpy as jnp
from jax import lax
import numpy as np

D_MODEL = 1024
BATCH = 8
SEQ = 8192
DEPTH = 1

ROPE_THETA = 10000.0
NORM_EPS = 1e-6
Q_BLOCK = 128

MLA_HEADS = 8
MLA_NOPE_DIM = 64
MLA_ROPE_DIM = 32
MLA_QK_DIM = MLA_NOPE_DIM + MLA_ROPE_DIM
MLA_V_DIM = 64
MLA_Q_LORA = 768
MLA_KV_LORA = 256
MLA_WIDTH = MLA_HEADS * MLA_V_DIM

DIFF_HEADS = 4
DIFF_HEAD_DIM = 64
DIFF_V_DIM = 2 * DIFF_HEAD_DIM
DIFF_WIDTH = DIFF_HEADS * DIFF_V_DIM

N_BRANCHES = 2
IN_WIDTH = MLA_Q_LORA + MLA_KV_LORA + MLA_ROPE_DIM + 3 * DIFF_WIDTH + N_BRANCHES * D_MODEL

N_EXPERTS = 32
TOP_K = 4
D_EXPERT = D_MODEL
SWIGLU_ALPHA = 1.702
SWIGLU_LIMIT = 7.0

kernel_name = 'hybrid_mla_diffattn_gated_moe'


def rms_norm(x, g):
    xf = x.astype(jnp.float32)
    y = xf * lax.rsqrt(jnp.mean(xf * xf, axis=-1, keepdims=True) + NORM_EPS)
    return (y * g.astype(jnp.float32)).astype(x.dtype)


def rope_tables(seq, dim):
    inv_freq = 1.0 / (ROPE_THETA ** (jnp.arange(0, dim, 2, dtype=jnp.float32) / dim))
    ang = jnp.arange(seq, dtype=jnp.float32)[:, None] * inv_freq[None, :]
    return jnp.cos(ang), jnp.sin(ang)


def apply_rope(x, cos, sin):
    xf = x.astype(jnp.float32)
    x1, x2 = jnp.split(xf, 2, axis=-1)
    c = cos[None, :, None, :]
    s = sin[None, :, None, :]
    return jnp.concatenate([x1 * c - x2 * s, x2 * c + x1 * s], axis=-1).astype(x.dtype)


def causal_block_attention(q, k, v, scale):
    b, s, h, dq = q.shape
    dv = v.shape[-1]
    nb = s // Q_BLOCK
    q_blocks = q.reshape(b, nb, Q_BLOCK, h, dq).transpose(1, 0, 2, 3, 4)
    key_pos = jnp.arange(s)

    def one_block(args):
        q_blk, blk = args
        sc = jnp.einsum('bqhd,bkhd->bhqk', q_blk, k, preferred_element_type=jnp.float32) * scale
        q_pos = blk * Q_BLOCK + jnp.arange(Q_BLOCK)
        mask = key_pos[None, :] <= q_pos[:, None]
        sc = jnp.where(mask[None, None], sc, -jnp.inf)
        p = jax.nn.softmax(sc, axis=-1)
        return jnp.einsum('bhqk,bkhd->bqhd', p.astype(v.dtype), v)

    out = lax.map(one_block, (q_blocks, jnp.arange(nb)))
    return out.transpose(1, 0, 2, 3, 4).reshape(b, s, h, dv)


def mla_branch(q_lat, kv_lat, k_pe, q_lat_norm, kv_lat_norm, w_uq, w_ukv, q_norm, k_norm, cos, sin):
    b, s, _ = q_lat.shape
    q = (rms_norm(q_lat, q_lat_norm) @ w_uq).reshape(b, s, MLA_HEADS, MLA_QK_DIM)
    kv = (rms_norm(kv_lat, kv_lat_norm) @ w_ukv).reshape(b, s, MLA_HEADS, MLA_NOPE_DIM + MLA_V_DIM)
    k_nope, v = kv[..., :MLA_NOPE_DIM], kv[..., MLA_NOPE_DIM:]
    k_pe = jnp.broadcast_to(k_pe[:, :, None, :], (b, s, MLA_HEADS, MLA_ROPE_DIM))
    k = jnp.concatenate([k_nope, k_pe], axis=-1)
    q = rms_norm(q, q_norm)
    k = rms_norm(k, k_norm)
    q = jnp.concatenate([q[..., :MLA_NOPE_DIM], apply_rope(q[..., MLA_NOPE_DIM:], cos, sin)], axis=-1)
    k = jnp.concatenate([k[..., :MLA_NOPE_DIM], apply_rope(k[..., MLA_NOPE_DIM:], cos, sin)], axis=-1)
    o = causal_block_attention(q, k, v, 1.0 / math.sqrt(MLA_QK_DIM))
    return o.reshape(b, s, MLA_WIDTH)


def diff_branch(q, k, v, q_norm, k_norm, lq1, lk1, lq2, lk2, subln, lambda_init, cos, sin):
    b, s, _ = q.shape
    q = rms_norm(q.reshape(b, s, 2 * DIFF_HEADS, DIFF_HEAD_DIM), q_norm)
    k = rms_norm(k.reshape(b, s, 2 * DIFF_HEADS, DIFF_HEAD_DIM), k_norm)
    q = apply_rope(q, cos, sin)
    k = apply_rope(k, cos, sin)
    v = jnp.repeat(v.reshape(b, s, DIFF_HEADS, DIFF_V_DIM), 2, axis=2)
    o = causal_block_attention(q, k, v, 1.0 / math.sqrt(DIFF_HEAD_DIM))
    o = o.reshape(b, s, DIFF_HEADS, 2, DIFF_V_DIM)
    lam = (jnp.exp(jnp.sum(lq1.astype(jnp.float32) * lk1.astype(jnp.float32)))
           - jnp.exp(jnp.sum(lq2.astype(jnp.float32) * lk2.astype(jnp.float32)))
           + lambda_init)
    o = o[..., 0, :] - lam.astype(o.dtype) * o[..., 1, :]
    o = rms_norm(o, subln) * (1.0 - lambda_init)
    return o.reshape(b, s, DIFF_WIDTH)


def moe_ffn(h, w_router, b_router, w1, b1, w2, b2):
    b, s, d = h.shape
    t = h.reshape(b * s, d)
    logits = (t @ w_router).astype(jnp.float32) + b_router.astype(jnp.float32)
    top_val, top_idx = lax.top_k(logits, TOP_K)
    top_w = jax.nn.softmax(top_val, axis=-1)
    gates = jnp.einsum('nk,nke->ne', top_w, jax.nn.one_hot(top_idx, N_EXPERTS, dtype=jnp.float32)).astype(h.dtype)
    out = jnp.zeros_like(t)
    for e in range(N_EXPERTS):
        u = t @ w1[e] + b1[e]
        glu = jnp.minimum(u[:, :D_EXPERT], SWIGLU_LIMIT)
        lin = jnp.clip(u[:, D_EXPERT:], -SWIGLU_LIMIT, SWIGLU_LIMIT)
        a = glu * jax.nn.sigmoid(SWIGLU_ALPHA * glu) * (lin + 1.0)
        out = out + gates[:, e:e + 1] * (a @ w2[e] + b2[e])
    return out.reshape(b, s, d)


def setup_inputs(seed: int = 0) -> dict:
    key = jax.random.key(seed)
    ks = jax.random.split(key, 32)
    f32 = jnp.float32

    def w(k, shape, fan_in):
        return jax.random.normal(k, shape, f32) * (fan_in ** -0.5)

    def gain(k, shape):
        return 1.0 + 0.01 * jax.random.normal(k, shape, f32)

    L = DEPTH
    return {
        'x': jax.random.normal(ks[0], (BATCH, SEQ, D_MODEL), f32),
        'attn_norm': gain(ks[1], (L, D_MODEL)),
        'w_in': w(ks[2], (L, D_MODEL, IN_WIDTH), D_MODEL),
        'mla_q_lat_norm': gain(ks[3], (L, MLA_Q_LORA)),
        'mla_kv_lat_norm': gain(ks[4], (L, MLA_KV_LORA)),
        'mla_w_uq': w(ks[5], (L, MLA_Q_LORA, MLA_HEADS * MLA_QK_DIM), MLA_Q_LORA),
        'mla_w_ukv': w(ks[6], (L, MLA_KV_LORA, MLA_HEADS * (MLA_NOPE_DIM + MLA_V_DIM)), MLA_KV_LORA),
        'mla_q_norm': gain(ks[7], (L, MLA_QK_DIM)),
        'mla_k_norm': gain(ks[8], (L, MLA_QK_DIM)),
        'diff_q_norm': gain(ks[9], (L, DIFF_HEAD_DIM)),
        'diff_k_norm': gain(ks[10], (L, DIFF_HEAD_DIM)),
        'diff_lambda_q1': 0.1 * jax.random.normal(ks[11], (L, DIFF_HEAD_DIM), f32),
        'diff_lambda_k1': 0.1 * jax.random.normal(ks[12], (L, DIFF_HEAD_DIM), f32),
        'diff_lambda_q2': 0.1 * jax.random.normal(ks[13], (L, DIFF_HEAD_DIM), f32),
        'diff_lambda_k2': 0.1 * jax.random.normal(ks[14], (L, DIFF_HEAD_DIM), f32),
        'diff_subln': gain(ks[15], (L, DIFF_V_DIM)),
        'w_branch_mla': w(ks[16], (L, MLA_WIDTH, D_MODEL), MLA_WIDTH),
        'w_branch_diff': w(ks[17], (L, DIFF_WIDTH, D_MODEL), DIFF_WIDTH),
        'w_out': w(ks[18], (L, D_MODEL, D_MODEL), D_MODEL),
        'ffn_norm': gain(ks[19], (L, D_MODEL)),
        'w_router': w(ks[20], (L, D_MODEL, N_EXPERTS), D_MODEL),
        'b_router': 0.01 * jax.random.normal(ks[21], (L, N_EXPERTS), f32),
        'w_mlp1': w(ks[22], (L, N_EXPERTS, D_MODEL, 2 * D_EXPERT), D_MODEL),
        'b_mlp1': 0.01 * jax.random.normal(ks[23], (L, N_EXPERTS, 2 * D_EXPERT), f32),
        'w_mlp2': w(ks[24], (L, N_EXPERTS, D_EXPERT, D_MODEL), D_EXPERT),
        'b_mlp2': 0.01 * jax.random.normal(ks[25], (L, N_EXPERTS, D_MODEL), f32),
    }


def reference(x, attn_norm, w_in, mla_q_lat_norm, mla_kv_lat_norm, mla_w_uq, mla_w_ukv,
              mla_q_norm, mla_k_norm, diff_q_norm, diff_k_norm, diff_lambda_q1, diff_lambda_k1,
              diff_lambda_q2, diff_lambda_k2, diff_subln, w_branch_mla, w_branch_diff, w_out,
              ffn_norm, w_router, b_router, w_mlp1, b_mlp1, w_mlp2, b_mlp2):
    s = x.shape[1]
    cos_mla, sin_mla = rope_tables(s, MLA_ROPE_DIM)
    cos_diff, sin_diff = rope_tables(s, DIFF_HEAD_DIM)
    split_points = list(np.cumsum([MLA_Q_LORA, MLA_KV_LORA, MLA_ROPE_DIM,
                                   DIFF_WIDTH, DIFF_WIDTH, DIFF_WIDTH, D_MODEL]))
    h = x
    for i in range(DEPTH):
        lambda_init = 0.8 - 0.6 * math.exp(-0.3 * i)
        xn = rms_norm(h, attn_norm[i])
        proj = xn @ w_in[i]
        q_lat, kv_lat, k_pe, dq, dk, dv, gate_a, gate_b = jnp.split(proj, split_points, axis=-1)
        o_a = mla_branch(q_lat, kv_lat, k_pe, mla_q_lat_norm[i], mla_kv_lat_norm[i], mla_w_uq[i],
                         mla_w_ukv[i], mla_q_norm[i], mla_k_norm[i], cos_mla, sin_mla)
        o_b = diff_branch(dq, dk, dv, diff_q_norm[i], diff_k_norm[i], diff_lambda_q1[i], diff_lambda_k1[i],
                          diff_lambda_q2[i], diff_lambda_k2[i], diff_subln[i], lambda_init, cos_diff, sin_diff)
        merged = (jax.nn.sigmoid(gate_a) * (o_a @ w_branch_mla[i])
                  + jax.nn.sigmoid(gate_b) * (o_b @ w_branch_diff[i]))
        h = h + merged @ w_out[i]
        h = h + moe_ffn(rms_norm(h, ffn_norm[i]), w_router[i], b_router[i],
                        w_mlp1[i], b_mlp1[i], w_mlp2[i], b_mlp2[i])
    return h
```

```cpp
#include <hip/hip_runtime.h>
#include <cstdio>
#include <cstdint>
#include <cmath>

#ifndef CFG_B
#define CFG_B 8
#endif
#ifndef CFG_S
#define CFG_S 8192
#endif
#ifndef USE_MFMA_GEMM
#define USE_MFMA_GEMM 1
#endif
#ifndef USE_MFMA_ATTN
#define USE_MFMA_ATTN 1
#endif
#ifndef ONE_LAUNCH
#define ONE_LAUNCH 1
#endif

#ifndef GEMM_PIPE
#define GEMM_PIPE 0
#endif
#ifndef FP8_GATES
#define FP8_GATES 1
#endif
#ifndef FP8_INPROJ
#define FP8_INPROJ 0
#endif
#ifndef ATTN_EXPERIMENT
#define ATTN_EXPERIMENT -1
#endif
#ifndef GEMM_EXPERIMENT
#define GEMM_EXPERIMENT -1
#endif
#ifndef PROBE_MASK
#define PROBE_MASK 0u
#endif

#define HD __host__ __device__ __forceinline__

constexpr int D_MODEL = 1024, BATCH = CFG_B, SEQ = CFG_S, NTOK = BATCH * SEQ;
constexpr int MLA_H = 8, QK = 96, QLORA = 768, KVLORA = 256;
constexpr int NE = 32, TOPK = 4;
constexpr float EPS = 1e-6f;
constexpr float LAMBDA_INIT = 0.2f;
constexpr float QSCALE_MLA = 0.10206207261596575f * 1.4426950408889634f, QSCALE_DIFF = 0.125f * 1.4426950408889634f;
constexpr float LN2 = 0.6931471805599453f;
constexpr int PC_QLAT = 0, PC_KVLAT = 768, PC_KPE = 1024, PC_DQ = 1280, PC_DK = 1792, PC_DV = 2304, PC_GA = 2816, PC_GB = 3840, PROJ_W = 4864;
constexpr int QA_W = 768;
constexpr int KV_W = 1280;
constexpr int OD_W = 1024;
#ifndef CFG_NHALF
#define CFG_NHALF 1
#endif
constexpr int NHALF = CFG_NHALF;
constexpr int HALF_TOK = NTOK / NHALF, HALF_SLOTS = HALF_TOK * TOPK;
constexpr int CHUNK = 256, NCHUNK = NTOK / CHUNK, CHUNK_PER_HALF = NCHUNK / NHALF;
constexpr int MAX_TILES = HALF_SLOTS / 256 + NE;

typedef unsigned short bf16_t;
typedef float f32x4 __attribute__((ext_vector_type(4)));
typedef unsigned u32x4 __attribute__((ext_vector_type(4)));

HD float bf2f(bf16_t v) { return __builtin_bit_cast(float, (unsigned)v << 16); }
#if defined(__HIP_DEVICE_COMPILE__)
HD unsigned pk2(float lo, float hi) { typedef float f2_t __attribute__((ext_vector_type(2))); typedef __bf16 b2_t __attribute__((ext_vector_type(2))); const f2_t v = {lo, hi}; return __builtin_bit_cast(unsigned, __builtin_convertvector(v, b2_t)); }
HD bf16_t f2bf(float f) { return (bf16_t)(pk2(f, 0.f) & 0xffffu); }
HD float sigmoidf_(float x) { return __builtin_amdgcn_rcpf(1.f + __builtin_amdgcn_exp2f(-1.4426950408889634f * x)); }
#else
HD bf16_t f2bf(float f) { unsigned u = __builtin_bit_cast(unsigned, f); return (bf16_t)((u + 0x7fffu + ((u >> 16) & 1u)) >> 16); }
HD unsigned pk2(float lo, float hi) { return (unsigned)f2bf(lo) | ((unsigned)f2bf(hi) << 16); }
HD float sigmoidf_(float x) { return 1.f / (1.f + expf(-x)); }
#endif
constexpr int EXP_T = 4, EXP_ACT = 2, EXP_W = 9, EXP_Y = 4;
HD unsigned char f2e4m3_sw(float f) {
    const unsigned u = __builtin_bit_cast(unsigned, f); const unsigned sign = (u >> 24) & 0x80u; float a = __builtin_bit_cast(float, u & 0x7fffffffu);
    if (!(a < 448.f)) return (unsigned char)(sign | 0x7e);
    if (a < 0.0009765625f) return (unsigned char)sign;
    int e; (void)frexpf(a, &e); e -= 1;
    if (e < -6) e = -6;
    const float q = ldexpf(1.f, e - 3); const float r = rintf(a / q);
    int m = (int)r;
    if (e == -6 && m < 8) return (unsigned char)(sign | m);
    if (m == 16) { m = 8; e += 1; }
    if (e > 8 || (e == 8 && m > 14)) return (unsigned char)(sign | 0x7e);
    return (unsigned char)(sign | ((e + 7) << 3) | (m - 8));
}
HD float e4m32f(unsigned char b) {
    const int e = (b >> 3) & 15, m = b & 7; float v = e == 0 ? ldexpf((float)m, -9) : ldexpf((float)(8 + m), e - 10);
    return (b & 0x80) ? -v : v;
}
HD unsigned pk4_e4m3(float a, float b, float cc, float d) {
#if defined(__HIP_DEVICE_COMPILE__)
    int w = __builtin_amdgcn_cvt_pk_fp8_f32(a, b, 0, false); w = __builtin_amdgcn_cvt_pk_fp8_f32(cc, d, w, true); return (unsigned)w;
#else
    return (unsigned)f2e4m3_sw(a) | ((unsigned)f2e4m3_sw(b) << 8) | ((unsigned)f2e4m3_sw(cc) << 16) | ((unsigned)f2e4m3_sw(d) << 24);
#endif
}
HD void load8_e4m3(const unsigned char* p, float* v, float mul) { typedef unsigned u2_t __attribute__((ext_vector_type(2))); const u2_t w = *(const u2_t*)p;
#if defined(__HIP_DEVICE_COMPILE__)
    typedef float f2_t __attribute__((ext_vector_type(2)));
    const f2_t a = __builtin_amdgcn_cvt_pk_f32_fp8((int)w.x, false), b = __builtin_amdgcn_cvt_pk_f32_fp8((int)w.x, true), cc = __builtin_amdgcn_cvt_pk_f32_fp8((int)w.y, false), d = __builtin_amdgcn_cvt_pk_f32_fp8((int)w.y, true);
    v[0] = a[0] * mul; v[1] = a[1] * mul; v[2] = b[0] * mul; v[3] = b[1] * mul; v[4] = cc[0] * mul; v[5] = cc[1] * mul; v[6] = d[0] * mul; v[7] = d[1] * mul;
#else
    for (int j = 0; j < 4; ++j) { v[j] = e4m32f((unsigned char)(w.x >> (8 * j))) * mul; v[4 + j] = e4m32f((unsigned char)(w.y >> (8 * j))) * mul; }
#endif
}
HD void store8_e4m3(unsigned char* p, const float* v, float mul) { typedef unsigned u2_t __attribute__((ext_vector_type(2))); u2_t w; w.x = pk4_e4m3(v[0] * mul, v[1] * mul, v[2] * mul, v[3] * mul); w.y = pk4_e4m3(v[4] * mul, v[5] * mul, v[6] * mul, v[7] * mul); *(u2_t*)p = w; }
HD void unpack8(const u32x4 w, float* v) {
    v[0] = __builtin_bit_cast(float, w.x << 16); v[1] = __builtin_bit_cast(float, w.x & 0xffff0000u);
    v[2] = __builtin_bit_cast(float, w.y << 16); v[3] = __builtin_bit_cast(float, w.y & 0xffff0000u);
    v[4] = __builtin_bit_cast(float, w.z << 16); v[5] = __builtin_bit_cast(float, w.z & 0xffff0000u);
    v[6] = __builtin_bit_cast(float, w.w << 16); v[7] = __builtin_bit_cast(float, w.w & 0xffff0000u);
}
HD u32x4 pack8(const float* v) { u32x4 w; w.x = pk2(v[0], v[1]); w.y = pk2(v[2], v[3]); w.z = pk2(v[4], v[5]); w.w = pk2(v[6], v[7]); return w; }
HD void load8(const bf16_t* p, float* v) { unpack8(*(const u32x4*)p, v); }
HD void store8(bf16_t* p, const float* v) { *(u32x4*)p = pack8(v); }
HD void pack8_gate(const float* v, unsigned& lo, unsigned& hi) { unsigned q[8];
#pragma unroll
    for (int j = 0; j < 8; ++j) q[j] = (unsigned)fminf(fmaxf(rintf(v[j] * 255.0f), 1.0f), 255.0f);
    lo = q[0] | (q[1] << 8) | (q[2] << 16) | (q[3] << 24); hi = q[4] | (q[5] << 8) | (q[6] << 16) | (q[7] << 24); }
HD void store8_gate(unsigned char* p, const float* v) { typedef unsigned u2_t __attribute__((ext_vector_type(2))); unsigned lo, hi; pack8_gate(v, lo, hi); u2_t w; w.x = lo; w.y = hi; *(u2_t*)p = w; }
HD void load8_gate(const unsigned char* p, float* v) { typedef unsigned u2_t __attribute__((ext_vector_type(2))); const u2_t w = *(const u2_t*)p;
#pragma unroll
    for (int j = 0; j < 4; ++j) { v[j] = (float)((w.x >> (8 * j)) & 255u) * (1.0f / 255.0f); v[4 + j] = (float)((w.y >> (8 * j)) & 255u) * (1.0f / 255.0f); } }

constexpr size_t MiB = (size_t)1 << 20;
constexpr size_t WS_CTL = 0;
constexpr size_t WS_WIN = 1 * MiB;
constexpr size_t WS_WUQ = 11 * MiB;
constexpr size_t WS_WUKV = 13 * MiB;
constexpr size_t WS_WBA = 14 * MiB, WS_WBB = 15 * MiB;
constexpr size_t WS_WOUT = 16 * MiB;
constexpr size_t WS_ROPE = 954 * MiB;
constexpr size_t WS_XN8 = 960 * MiB;
constexpr int FP8_PN0 = 11, FP8_C0 = FP8_PN0 * 256;
constexpr size_t WS_WIN8 = 1 * MiB + (size_t)FP8_C0 * 2048;
constexpr size_t WS_WRH = 958 * MiB, WS_WRL = 958 * MiB + 65536;
constexpr size_t WS_TOPI = 19 * MiB;
constexpr size_t WS_TOPW = 20 * MiB;
constexpr size_t WS_SLOT = 21 * MiB;
constexpr size_t WS_TOKOF = 22 * MiB;
constexpr size_t WS_WOF = 23 * MiB;
constexpr size_t WS_RSOF = 25 * MiB;
constexpr size_t WS_HB = 762 * MiB;
constexpr size_t WS_SSP = 19 * MiB;
constexpr size_t WS_MISC = 24 * MiB;
constexpr size_t WS_LOGIT = 400 * MiB;
constexpr size_t WS_PROJ = 26 * MiB;
constexpr size_t WS_XN = 634 * MiB;
constexpr size_t WS_QA = 634 * MiB;
constexpr size_t WS_KV = 730 * MiB;
constexpr size_t WS_OA = 890 * MiB;
constexpr size_t WS_OD = 634 * MiB;
constexpr size_t WS_OB = 960 * MiB;
constexpr size_t WS_MERGED = 634 * MiB;
constexpr size_t WS_W1 = 26 * MiB;
constexpr size_t WS_W2 = 154 * MiB;
constexpr size_t WS_T = 186 * MiB;
constexpr size_t WS_ACT = 250 * MiB;
constexpr size_t WS_Y = 506 * MiB;
constexpr size_t WS_END = 1024 * MiB;
constexpr size_t MS_CHUNKCNT = 0;
constexpr size_t MS_CHUNKBASE = 64 * 1024;
constexpr size_t MS_EBASE = 128 * 1024;
constexpr size_t MS_NTILES = 132 * 1024;
constexpr size_t MS_TILES = 136 * 1024;
constexpr size_t MS_LAMBDA = 256 * 1024;
constexpr size_t MS_RSTD = 512 * 1024;
constexpr size_t MS_RQ = 768 * 1024;
constexpr size_t MS_SBOUND = 260 * 1024;
constexpr int CW_BAR = 4096;

struct Params {
    const float* x; const float* attn_norm; const float* w_in; const float* q_lat_norm; const float* kv_lat_norm; const float* w_uq; const float* w_ukv;
    const float* mla_q_norm; const float* mla_k_norm; const float* diff_q_norm; const float* diff_k_norm; const float* lq1; const float* lk1; const float* lq2; const float* lk2;
    const float* subln; const float* w_ba; const float* w_bb; const float* w_out; const float* ffn_norm; const float* w_router; const float* b_router;
    const float* w1; const float* b1; const float* w2; const float* b2;
    float* out; unsigned char* ws;
    int ph_lo, ph_hi;
};
template <class T> HD T* wsp(const Params& p, size_t off) { return (T*)(p.ws + off); }

HD void wt_item(const float* src, int N, bf16_t* dst, int K, int n_dst, int n_src, int k0, const float* gain) {
    float v[8];
#pragma unroll
    for (int j = 0; j < 8; ++j) { float s = (n_src >= 0) ? src[(size_t)(k0 + j) * N + n_src] : 0.f; if (gain) s *= gain[k0 + j]; v[j] = s; }
    store8(dst + (size_t)n_dst * K + k0, v);
}
HD void wt_item8(const float* src, int N, unsigned char* dst, int K, int n_dst, int n_src, int k0, float mul) {
    float v[8];
#pragma unroll
    for (int j = 0; j < 8; ++j) v[j] = src[(size_t)(k0 + j) * N + n_src];
    store8_e4m3(dst + (size_t)n_dst * K + k0, v, mul);
}
HD int win_src_col(int pc) { return pc < 1056 ? pc : (pc < 1280 ? -1 : pc - 224); }
HD int wukv_src_col(int c) { const int h = c / 160, j = c % 160; return j < 64 ? h * 128 + j : (j < 96 ? -1 : h * 128 + 64 + (j - 96)); }
HD int w1_src_col(int n) { const int pn = n >> 8, j = n & 255; return j < 128 ? pn * 128 + j : 1024 + pn * 128 + (j - 128); }

constexpr int IT_WIN = PROJ_W * (1024 / 8), IT_WUQ = 768 * (768 / 8), IT_WUKV = 1024 * (256 / 8), IT_WB = 1024 * (512 / 8), IT_WOUT = 1024 * (1024 / 8);
constexpr int IT_SMALLW = IT_WIN + IT_WUQ + IT_WUKV + 2 * IT_WB + IT_WOUT;
HD void smallw_item(const Params& p, int it) {
#if FP8_INPROJ
    if (it < IT_WIN) { const int kc = it / PROJ_W, n = it % PROJ_W; const int sc = win_src_col(n); if (sc >= 0) wt_item8(p.w_in, 4640, wsp<unsigned char>(p, WS_WIN), 1024, n, sc, kc * 8, (float)(1 << EXP_W)); else { float z[8] = {0, 0, 0, 0, 0, 0, 0, 0}; store8_e4m3(wsp<unsigned char>(p, WS_WIN) + (size_t)n * 1024 + kc * 8, z, 1.f); } return; } it -= IT_WIN;
#else
    if (it < IT_WIN) { const int kc = it / PROJ_W, n = it % PROJ_W;
        if (FP8_GATES && n >= FP8_C0) wt_item8(p.w_in, 4640, wsp<unsigned char>(p, WS_WIN8), 1024, n - FP8_C0, win_src_col(n), kc * 8, (float)(1 << EXP_W));
        else wt_item(p.w_in, 4640, wsp<bf16_t>(p, WS_WIN), 1024, n, win_src_col(n), kc * 8, nullptr); return; } it -= IT_WIN;
#endif
    if (it < IT_WUQ) { const int kc = it / 768, n = it % 768; wt_item(p.w_uq, 768, wsp<bf16_t>(p, WS_WUQ), 768, n, n, kc * 8, p.q_lat_norm); return; } it -= IT_WUQ;
    if (it < IT_WUKV) { const int kc = it / 1024, n = it % 1024; wt_item(p.w_ukv, 1024, wsp<bf16_t>(p, WS_WUKV), 256, n, n, kc * 8, p.kv_lat_norm); return; } it -= IT_WUKV;
    if (it < IT_WB) { const int kc = it / 1024, n = it % 1024; wt_item(p.w_ba, 1024, wsp<bf16_t>(p, WS_WBA), 512, n, n, kc * 8, nullptr); return; } it -= IT_WB;
    if (it < IT_WB) { const int kc = it / 1024, n = it % 1024; wt_item(p.w_bb, 1024, wsp<bf16_t>(p, WS_WBB), 512, n, n, kc * 8, nullptr); return; } it -= IT_WB;
    { const int kc = it / 1024, n = it % 1024; wt_item(p.w_out, 1024, wsp<bf16_t>(p, WS_WOUT), 1024, n, n, kc * 8, nullptr); }
}
constexpr long IT_W1 = (long)NE * 2048 * 128, IT_W2 = (long)NE * 1024 * 128, IT_MOEW = IT_W1 + IT_W2;
HD void moew_item(const Params& p, long it) {
    if (it < IT_W1) { const int e = (int)(it / (2048 * 128)), r = (int)(it % (2048 * 128)), kc = r / 2048, n = r % 2048;
        wt_item8(p.w1 + (size_t)e * 1024 * 2048, 2048, wsp<unsigned char>(p, WS_W1) + (size_t)e * 2048 * 1024, 1024, n, w1_src_col(n), kc * 8, (float)(1 << EXP_W)); return; }
    it -= IT_W1;
    { const int e = (int)(it / (1024 * 128)), r = (int)(it % (1024 * 128)), kc = r / 1024, n = r % 1024;
        wt_item8(p.w2 + (size_t)e * 1024 * 1024, 1024, wsp<unsigned char>(p, WS_W2) + (size_t)e * 1024 * 1024, 1024, n, n, kc * 8, (float)(1 << EXP_W)); }
}

HD void rope_item(float* tab, int nf, int dim, int pos, int i) {
    const float inv = 1.0f / powf(10000.0f, (float)(2 * i) / (float)dim);
    const float ang = (float)pos * inv;
    const double a = (double)ang; const double n = rint(a * 0.63661977236758134308); const double r = a - n * 1.57079632679489661923;
    const double r2 = r * r;
    const double s = r * (1.0 + r2 * (-1.0 / 6 + r2 * (1.0 / 120 + r2 * (-1.0 / 5040 + r2 * (1.0 / 362880 - r2 * (1.0 / 39916800))))));
    const double c = 1.0 + r2 * (-0.5 + r2 * (1.0 / 24 + r2 * (-1.0 / 720 + r2 * (1.0 / 40320 + r2 * (-1.0 / 3628800 + r2 * (1.0 / 479001600))))));
    const int q = ((int)n) & 3; double cs, sn;
    if (q == 0) { cs = c; sn = s; } else if (q == 1) { cs = -s; sn = c; } else if (q == 2) { cs = -c; sn = -s; } else { cs = s; sn = -c; }
    tab[((size_t)pos * nf + i) * 2 + 0] = (float)cs; tab[((size_t)pos * nf + i) * 2 + 1] = (float)sn;
}
constexpr int IT_ROPE = SEQ * 48;
HD void rope_tab_item(const Params& p, int it) {
    float* tab = wsp<float>(p, WS_ROPE);
    const int pos = it / 48, i = it % 48;
    if (i < 16) rope_item(tab, 16, 32, pos, i); else rope_item(tab + (size_t)SEQ * 16 * 2, 32, 64, pos, i - 16);
}
HD void sbound_item(const Params& p) {
    float gq = 0.f, gk = 0.f, dq = 0.f, dk = 0.f;
    for (int i = 0; i < 96; ++i) { gq = fmaxf(gq, fabsf(p.mla_q_norm[i])); gk = fmaxf(gk, fabsf(p.mla_k_norm[i])); }
    for (int i = 0; i < 64; ++i) { dq = fmaxf(dq, fabsf(p.diff_q_norm[i])); dk = fmaxf(dk, fabsf(p.diff_k_norm[i])); }
    float* sb = wsp<float>(p, WS_MISC + MS_SBOUND);
    sb[0] = 1.01f * 96.f * QSCALE_MLA * gq * gk; sb[1] = 1.01f * 64.f * QSCALE_DIFF * dq * dk;
}
HD void lambda_item(const Params& p) {
    float a = 0.f, b = 0.f;
    for (int i = 0; i < 64; ++i) { a += p.lq1[i] * p.lk1[i]; b += p.lq2[i] * p.lk2[i]; }
    *wsp<float>(p, WS_MISC + MS_LAMBDA) = expf(a) - expf(b) + LAMBDA_INIT;
}

HD void xn_row_scalar(const Params& p, int token) {
    const float* xr = p.x + (size_t)token * 1024; float ss = 0.f;
    for (int c = 0; c < 1024; ++c) ss += xr[c] * xr[c];
    const float rs = 1.0f / sqrtf(ss * (1.0f / 1024) + EPS);
#if FP8_INPROJ
    unsigned char* o = wsp<unsigned char>(p, WS_XN) + (size_t)token * 1024;
    for (int c = 0; c < 1024; c += 8) { float v[8]; for (int j = 0; j < 8; ++j) v[j] = xr[c + j] * rs * p.attn_norm[c + j]; store8_e4m3(o + c, v, (float)(1 << EXP_T)); }
#else
    bf16_t* o = wsp<bf16_t>(p, WS_XN) + (size_t)token * 1024;
    for (int c = 0; c < 1024; ++c) o[c] = f2bf(xr[c] * rs * p.attn_norm[c]);
#endif
#if FP8_GATES
    { unsigned char* o8 = wsp<unsigned char>(p, WS_XN8) + (size_t)token * 1024;
      for (int c = 0; c < 1024; c += 8) { float v[8]; for (int j = 0; j < 8; ++j) v[j] = xr[c + j] * rs * p.attn_norm[c + j]; store8_e4m3(o8 + c, v, (float)(1 << EXP_T)); } }
#endif
}

template <int HDIM, int NF, class SRC> HD void norm_rope_stream(const SRC& src, bf16_t* dst, const float* gain, const float* tab, float oscale) {
    float ss = 0.f;
#pragma unroll 2
    for (int c = 0; c < HDIM / 8; ++c) { float v[8]; src.load(c, v);
#pragma unroll
        for (int j = 0; j < 8; ++j) ss += v[j] * v[j]; }
    const float rs = oscale / sqrtf(ss * (1.0f / HDIM) + EPS);
    constexpr int R0 = (HDIM - 2 * NF) / 8, NC = NF / 8;
#pragma unroll 2
    for (int c = 0; c < R0; ++c) { float v[8]; src.load(c, v);
#pragma unroll
        for (int j = 0; j < 8; ++j) v[j] = v[j] * rs * gain[c * 8 + j];
        store8(dst + c * 8, v); }
#pragma unroll 1
    for (int i = 0; i < NC; ++i) { float a[8], b[8]; src.load(R0 + i, a); src.load(R0 + NC + i, b);
#pragma unroll
        for (int j = 0; j < 8; ++j) { const float x1 = a[j] * rs * gain[(R0 + i) * 8 + j], x2 = b[j] * rs * gain[(R0 + NC + i) * 8 + j]; const float cs = tab[2 * (i * 8 + j)], sn = tab[2 * (i * 8 + j) + 1];
            a[j] = x1 * cs - x2 * sn; b[j] = x2 * cs + x1 * sn; }
        store8(dst + (R0 + i) * 8, a); store8(dst + (R0 + NC + i) * 8, b); }
}
HD float row_rstd_bf16(const bf16_t* row, int n) {
    float ss = 0.f;
#pragma unroll 4
    for (int c = 0; c < n; c += 8) { float v[8]; load8(row + c, v);
#pragma unroll
        for (int j = 0; j < 8; ++j) ss += v[j] * v[j]; }
    return 1.0f / sqrtf(ss / (float)n + EPS);
}
struct SrcScaled { const bf16_t* p; float s; HD void load(int c, float* v) const { load8(p + c * 8, v);
#pragma unroll
    for (int j = 0; j < 8; ++j) v[j] *= s; } };
struct SrcK { const bf16_t* kv; const bf16_t* kpe; float s; HD void load(int c, float* v) const { if (c < 8) { load8(kv + c * 8, v);
#pragma unroll
    for (int j = 0; j < 8; ++j) v[j] *= s; } else load8(kpe + (c - 8) * 8, v); } };
HD void post_item(const Params& p, long item, float rq, float rkv) {
    const int token = (int)(item >> 5), s = (int)(item & 31), pos = token % SEQ;
    const bf16_t* proj = wsp<bf16_t>(p, WS_PROJ) + (size_t)token * PROJ_W;
    const float* tab_mla = wsp<float>(p, WS_ROPE) + (size_t)pos * 16 * 2;
    const float* tab_diff = wsp<float>(p, WS_ROPE) + (size_t)SEQ * 16 * 2 + (size_t)pos * 32 * 2;
    if (s < 8) {
        bf16_t* q = wsp<bf16_t>(p, WS_QA) + (size_t)token * QA_W + s * 96;
        norm_rope_stream<96, 16>(SrcScaled{q, rq}, q, p.mla_q_norm, tab_mla, QSCALE_MLA);
    } else if (s < 16) {
        const int h = s - 8;
        bf16_t* kv = wsp<bf16_t>(p, WS_KV) + (size_t)token * KV_W + h * 160;
        norm_rope_stream<96, 16>(SrcK{kv, proj + PC_KPE, rkv}, kv, p.mla_k_norm, tab_mla, 1.0f);
#pragma unroll 2
        for (int c = 0; c < 64; c += 8) { float v[8]; load8(kv + 96 + c, v);
#pragma unroll
            for (int j = 0; j < 8; ++j) v[j] *= rkv;
            store8(kv + 96 + c, v); }
    } else {
        const int sub = (s - 16) & 7; const bool isk = s >= 24;
        bf16_t* q = wsp<bf16_t>(p, WS_PROJ) + (size_t)token * PROJ_W + (isk ? PC_DK : PC_DQ) + sub * 64;
        norm_rope_stream<64, 32>(SrcScaled{q, 1.0f}, q, isk ? p.diff_k_norm : p.diff_q_norm, tab_diff, isk ? 1.0f : QSCALE_DIFF);
    }
}

HD void combine_item(const Params& p, long item) {
    const int token = (int)(item >> 2), h = (int)(item & 3);
    const float lam = *wsp<float>(p, WS_MISC + MS_LAMBDA);
    const bf16_t* od = wsp<bf16_t>(p, WS_OD) + (size_t)token * OD_W + h * 256;
    float ss = 0.f;
#pragma unroll 2
    for (int c = 0; c < 128; c += 8) { float a[8], b[8]; load8(od + c, a); load8(od + 128 + c, b);
#pragma unroll
        for (int j = 0; j < 8; ++j) { const float v = a[j] - lam * b[j]; ss += v * v; } }
    const float rs = 1.0f / sqrtf(ss * (1.0f / 128) + EPS);
    bf16_t* ob = wsp<bf16_t>(p, WS_OB) + (size_t)token * 512 + h * 128;
#pragma unroll 2
    for (int c = 0; c < 128; c += 8) { float a[8], b[8], o[8]; load8(od + c, a); load8(od + 128 + c, b);
#pragma unroll
        for (int j = 0; j < 8; ++j) o[j] = (a[j] - lam * b[j]) * rs * p.subln[c + j] * (1.0f - LAMBDA_INIT);
        store8(ob + c, o); }
}

HD void wr_frag_item(const Params& p, int item) {
    const int s = item >> 6, l = item & 63, e = l & 31, kb = 16 * s + 8 * (l >> 5);
    float hi[8], lo[8];
#pragma unroll
    for (int j = 0; j < 8; ++j) { const float v = p.ffn_norm[kb + j] * p.w_router[(size_t)(kb + j) * NE + e]; const float h = bf2f(f2bf(v)); hi[j] = h; lo[j] = v - h; }
    store8(wsp<bf16_t>(p, WS_WRH) + (size_t)item * 8, hi); store8(wsp<bf16_t>(p, WS_WRL) + (size_t)item * 8, lo);
}
HD void ffn_rstd_scalar(const Params& p, int token) {
    const float* hr = p.out + (size_t)token * 1024; float ss = 0.f;
    for (int c = 0; c < 1024; ++c) ss += hr[c] * hr[c];
    wsp<float>(p, WS_MISC + MS_RSTD)[token] = 1.0f / sqrtf(ss * (1.0f / 1024) + EPS);
}
HD void t_item(const Params& p, long item) {
    const int token = (int)(item >> 7), c0 = (int)(item & 127) * 8;
    const float rs = wsp<float>(p, WS_MISC + MS_RSTD)[token];
    const float* hr = p.out + (size_t)token * 1024 + c0; float v[8];
#pragma unroll
    for (int j = 0; j < 8; ++j) v[j] = hr[j] * rs * p.ffn_norm[c0 + j];
    store8_e4m3(wsp<unsigned char>(p, WS_T) + (size_t)token * 1024 + c0, v, (float)(1 << EXP_T));
}
HD void logit_item(const Params& p, long item) {
    const int token = (int)(item >> 5), e = (int)(item & 31);
    const float rs = wsp<float>(p, WS_MISC + MS_RSTD)[token];
    const float* hr = p.out + (size_t)token * 1024; float acc = 0.f;
    for (int c = 0; c < 1024; ++c) acc += (hr[c] * rs * p.ffn_norm[c]) * p.w_router[c * NE + e];
    wsp<float>(p, WS_LOGIT)[(size_t)token * NE + e] = acc + p.b_router[e];
}
HD void top4_item(const Params& p, int token) {
    const float* lg = wsp<float>(p, WS_LOGIT) + (size_t)token * NE;
    float v[NE];
#pragma unroll
    for (int e = 0; e < NE; ++e) v[e] = lg[e];
    int idx[4]; float val[4];
#pragma unroll
    for (int k = 0; k < 4; ++k) { int bi = 0; float bv = -INFINITY;
#pragma unroll
        for (int e = 0; e < NE; ++e) { const bool taken = (k > 0 && idx[0] == e) || (k > 1 && idx[1] == e) || (k > 2 && idx[2] == e); if (!taken && v[e] > bv) { bv = v[e]; bi = e; } }
        idx[k] = bi; val[k] = bv; }
    const float m = val[0]; float ex[4], sum = 0.f;
#pragma unroll
    for (int k = 0; k < 4; ++k) { ex[k] = expf(val[k] - m); sum += ex[k]; }
    int* ti = wsp<int>(p, WS_TOPI) + (size_t)token * 4; float* tw = wsp<float>(p, WS_TOPW) + (size_t)token * 4;
#pragma unroll
    for (int k = 0; k < 4; ++k) { ti[k] = idx[k]; tw[k] = ex[k] / sum; }
}
HD void chunkcnt_item(const Params& p, int item) {
    const int chunk = item >> 5, e = item & 31; const int* ti = wsp<int>(p, WS_TOPI) + (size_t)chunk * CHUNK * 4; int c = 0;
    for (int i = 0; i < CHUNK * 4; ++i) c += (ti[i] == e) ? 1 : 0;
    wsp<int>(p, WS_MISC + MS_CHUNKCNT)[item] = c;
}
HD void route_expert_item(const Params& p, int e) {
    const int* cc = wsp<int>(p, WS_MISC + MS_CHUNKCNT); int* cb = wsp<int>(p, WS_MISC + MS_CHUNKBASE); int* eb = wsp<int>(p, WS_MISC + MS_EBASE);
    for (int hf = 0; hf < NHALF; ++hf) { int run = 0;
        for (int ch = hf * CHUNK_PER_HALF; ch < (hf + 1) * CHUNK_PER_HALF; ++ch) { cb[ch * 32 + e] = run; run += cc[ch * 32 + e]; }
        eb[hf * 33 + e] = run; }
}
HD void route_final_item(const Params& p) {
    int* eb = wsp<int>(p, WS_MISC + MS_EBASE); int* nt = wsp<int>(p, WS_MISC + MS_NTILES); int* tl = wsp<int>(p, WS_MISC + MS_TILES);
    for (int hf = 0; hf < NHALF; ++hf) { int run = 0, n = 0;
        for (int e = 0; e < NE; ++e) { const int cnt = eb[hf * 33 + e]; eb[hf * 33 + e] = run;
            for (int r = 0; r < cnt; r += 256) { int* t = tl + ((size_t)hf * MAX_TILES + n) * 4; t[0] = e; t[1] = run + r; t[2] = (cnt - r) < 256 ? (cnt - r) : 256; t[3] = 0; ++n; }
            run += cnt; }
        eb[hf * 33 + NE] = run; nt[hf] = n; }
}
HD void slot_item(const Params& p, long item, int base) {
    const int token = (int)(item >> 2), chunk = token / CHUNK, hf = chunk / CHUNK_PER_HALF;
    const int* ti = wsp<int>(p, WS_TOPI); const int e = ti[item];
    int rank = 0;
    for (int t = chunk * CHUNK; t < token; ++t) { const int* q = ti + (size_t)t * 4; rank += (q[0] == e) + (q[1] == e) + (q[2] == e) + (q[3] == e); }
    const int slot = base + rank;
    wsp<int>(p, WS_SLOT)[item] = slot;
    wsp<int>(p, WS_TOKOF)[(size_t)hf * HALF_SLOTS + slot] = token;
    wsp<float>(p, WS_WOF)[(size_t)hf * HALF_SLOTS + slot] = wsp<float>(p, WS_TOPW)[item];
}
HD int slot_base_global(const Params& p, long item) { const int token = (int)(item >> 2), chunk = token / CHUNK, hf = chunk / CHUNK_PER_HALF; const int e = wsp<int>(p, WS_TOPI)[item];
    return wsp<int>(p, WS_MISC + MS_EBASE)[hf * 33 + e] + wsp<int>(p, WS_MISC + MS_CHUNKBASE)[chunk * 32 + e]; }
HD void final_item(const Params& p, int hf, long item) {
    const int token = hf * HALF_TOK + (int)(item >> 7), c0 = (int)(item & 127) * 8;
    const int* sl = wsp<int>(p, WS_SLOT) + (size_t)token * 4; const unsigned char* Y = wsp<unsigned char>(p, WS_Y);
    float* o = p.out + (size_t)token * 1024 + c0; float acc[8];
    load8(wsp<bf16_t>(p, WS_HB) + (size_t)token * 1024 + c0, acc);
#pragma unroll
    for (int k = 0; k < 4; ++k) { float y[8]; load8_e4m3(Y + (size_t)sl[k] * 1024 + c0, y, 1.0f / (float)(1 << EXP_Y));
#pragma unroll
        for (int j = 0; j < 8; ++j) acc[j] += y[j]; }
#pragma unroll
    for (int j = 0; j < 8; ++j) o[j] = acc[j];
}

struct Unit { int row0, pn, nrows, aux; };
typedef f32x4 Acc[2][2][4][2];
HD void acc8(const Acc& acc, int ai, int bj, int m, float* v) {
    const f32x4 a = acc[ai][bj][m][0], b = acc[ai][bj][m][1];
    v[0] = a[0]; v[1] = a[1]; v[2] = a[2]; v[3] = a[3]; v[4] = b[0]; v[5] = b[1]; v[6] = b[2]; v[7] = b[3];
}
struct GridPos { int G, c; };
HD bool static_order(const GridPos& g, long L, int nM, int nN, int& pm, int& pn) {
    const long nwg = (long)nM * nN; if (L >= nwg) return false;
    long wgid = L; { const long q = nwg / 8, r = nwg % 8, xcd = wgid % 8, off = wgid / 8; wgid = (xcd < r ? xcd * (q + 1) : r * (q + 1) + (xcd - r) * q) + off; }
    const int WGM = 8; const long nig = (long)WGM * nN; const int gid = (int)(wgid / nig), fm = gid * WGM, gsz = (nM - fm) < WGM ? (nM - fm) : WGM;
    pm = fm + (int)((wgid % nig) % gsz); pn = (int)((wgid % nig) / gsz); return true;
}
#if defined(__HIP_DEVICE_COMPILE__)
#define HD_SCHED_BARRIER() __builtin_amdgcn_sched_barrier(0)
#else
#define HD_SCHED_BARRIER() do { } while (0)
#endif
#define FOR_AI_M _Pragma("unroll") for (int ai = 0; ai < 2; ++ai) _Pragma("unroll") for (int m = 0; m < 4; ++m)
#define FOR_BJ _Pragma("unroll") for (int bj = 0; bj < 2; ++bj)
#define FOR_J8 _Pragma("unroll") for (int j = 0; j < 8; ++j)

constexpr bool GATES_U8 = FP8_GATES && (FP8_PN0 * 256 == PC_GA);
struct ProbInProj {
    static constexpr bool HAS_MID = false;
#if FP8_INPROJ
    static constexpr int ESZ = 1, EXA = EXP_T, EXB = EXP_W; typedef unsigned char el_t;
#else
    static constexpr int ESZ = 2, EXA = 0, EXB = 0; typedef bf16_t el_t;
#endif
    GridPos g; const el_t* A_; const el_t* Bt; bf16_t* P; float* ssp;
    HD int K() const { return 1024; }
    HD const el_t* A() const { return A_; }
    HD size_t arow(const Unit& u, int r) const { return (size_t)(u.row0 + r) * 1024; }
    HD const el_t* B(const Unit& u) const { return Bt + (size_t)u.pn * 256 * 1024; }
    HD bool next(int i, Unit& u) const { int pm, pn; if (!static_order(g, (long)i * g.G + g.c, NTOK / 256, FP8_GATES ? FP8_PN0 : 19, pm, pn)) return false; u.row0 = pm * 256; u.pn = pn; u.nrows = 256; u.aux = 0; return true; }
    HD void epi(const Acc& acc, const Unit& u, int wr, int wc, int fr, int fq) const {
        const bool gate = u.pn * 256 >= PC_GA;
        FOR_AI_M { const int tr = 128 * ai + 64 * wr + 16 * m + fr; float ssq = 0.f;
            FOR_BJ { float v[8]; acc8(acc, ai, bj, m, v);
                if (gate) { FOR_J8 v[j] = sigmoidf_(v[j]); }
                FOR_J8 ssq += v[j] * v[j];
                store8(P + (size_t)(u.row0 + tr) * PROJ_W + u.pn * 256 + 128 * bj + 32 * wc + 8 * fq, v); }
#if defined(__HIP_DEVICE_COMPILE__)
            if (u.pn < 4) { ssq += __shfl_xor(ssq, 16); ssq += __shfl_xor(ssq, 32);
                if (fq == 0) ssp[(size_t)(u.row0 + tr) * 16 + u.pn * 4 + wc] = ssq; }
#endif
        }
    }
};
struct ProbInProjG {
    static constexpr bool HAS_MID = false;
    static constexpr int ESZ = 1, EXA = EXP_T, EXB = EXP_W;
    GridPos g; const unsigned char* A_; const unsigned char* Bt; bf16_t* P;
    HD int K() const { return 1024; }
    HD const unsigned char* A() const { return A_; }
    HD size_t arow(const Unit& u, int r) const { return (size_t)(u.row0 + r) * 1024; }
    HD const unsigned char* B(const Unit& u) const { return Bt + (size_t)(u.pn - FP8_PN0) * 256 * 1024; }
    HD bool next(int i, Unit& u) const { int pm, pn; if (!static_order(g, (long)i * g.G + g.c, NTOK / 256, 19 - FP8_PN0, pm, pn)) return false; u.row0 = pm * 256; u.pn = FP8_PN0 + pn; u.nrows = 256; u.aux = 0; return true; }
    HD void epi(const Acc& acc, const Unit& u, int wr, int wc, int fr, int fq) const {
#if defined(__HIP_DEVICE_COMPILE__)
        if (GATES_U8) {
            _Pragma("unroll") for (int ai = 0; ai < 2; ++ai) _Pragma("unroll") for (int mp = 0; mp < 4; mp += 2) { unsigned px[2][2], py[2][2];
                _Pragma("unroll") for (int d = 0; d < 2; ++d) FOR_BJ { float v[8]; acc8(acc, ai, bj, mp + d, v); FOR_J8 v[j] = sigmoidf_(v[j]); pack8_gate(v, px[bj][d], py[bj][d]); }
                const int tr = 128 * ai + 64 * wr + 16 * (mp + (fq & 1)) + fr; unsigned char* g8 = (unsigned char*)(P + (size_t)(u.row0 + tr) * PROJ_W + PC_GA) + (u.pn * 256 - PC_GA);
                FOR_BJ { const auto sx = __builtin_amdgcn_permlane16_swap(px[bj][0], px[bj][1], false, false); const auto sy = __builtin_amdgcn_permlane16_swap(py[bj][0], py[bj][1], false, false);
                    *(u32x4*)(g8 + 128 * bj + 32 * wc + 8 * (fq & ~1)) = (u32x4){sx[0], sy[0], sx[1], sy[1]}; } }
            return; }
#endif
        FOR_AI_M { const int tr = 128 * ai + 64 * wr + 16 * m + fr;
            FOR_BJ { float v[8]; acc8(acc, ai, bj, m, v); if (u.pn * 256 >= PC_GA) { FOR_J8 v[j] = sigmoidf_(v[j]); }
                if (GATES_U8) store8_gate((unsigned char*)(P + (size_t)(u.row0 + tr) * PROJ_W + PC_GA) + (u.pn * 256 - PC_GA) + 128 * bj + 32 * wc + 8 * fq, v);
                else store8(P + (size_t)(u.row0 + tr) * PROJ_W + u.pn * 256 + 128 * bj + 32 * wc + 8 * fq, v); } }
    }
};
struct ProbUpQ {
    static constexpr bool HAS_MID = false;
    static constexpr int ESZ = 2, EXA = 0, EXB = 0;
    GridPos g; const bf16_t* proj; const bf16_t* wt; bf16_t* O;
    HD int K() const { return 768; }
    HD const bf16_t* A() const { return proj + PC_QLAT; }
    HD size_t arow(const Unit& u, int r) const { return (size_t)(u.row0 + r) * PROJ_W; }
    HD const bf16_t* B(const Unit& u) const { return wt + (size_t)u.pn * 256 * 768; }
    HD bool next(int i, Unit& u) const { int pm, pn; if (!static_order(g, (long)i * g.G + g.c, NTOK / 256, 3, pm, pn)) return false; u.row0 = pm * 256; u.pn = pn; u.nrows = 256; u.aux = 0; return true; }
    HD void epi(const Acc& acc, const Unit& u, int wr, int wc, int fr, int fq) const {
        FOR_AI_M { const int tr = 128 * ai + 64 * wr + 16 * m + fr;
            FOR_BJ { float v[8]; acc8(acc, ai, bj, m, v); store8(O + (size_t)(u.row0 + tr) * QA_W + u.pn * 256 + 128 * bj + 32 * wc + 8 * fq, v); } }
    }
};
struct ProbUpKV {
    static constexpr bool HAS_MID = false;
    static constexpr int ESZ = 2, EXA = 0, EXB = 0;
    GridPos g; const bf16_t* proj; const bf16_t* wt; bf16_t* O; const float* ssp;
    HD int K() const { return 256; }
    HD const bf16_t* A() const { return proj + PC_KVLAT; }
    HD size_t arow(const Unit& u, int r) const { return (size_t)(u.row0 + r) * PROJ_W; }
    HD const bf16_t* B(const Unit& u) const { return wt + (size_t)u.pn * 256 * 256; }
    HD bool next(int i, Unit& u) const { int pm, pn; if (!static_order(g, (long)i * g.G + g.c, NTOK / 256, 4, pm, pn)) return false; u.row0 = pm * 256; u.pn = pn; u.nrows = 256; u.aux = 0; return true; }
    HD void epi(const Acc& acc, const Unit& u, int wr, int wc, int fr, int fq) const {
        float rkv[2][4];
        FOR_AI_M { const f32x4 q = *(const f32x4*)(ssp + (size_t)(u.row0 + 128 * ai + 64 * wr + 16 * m + fr) * 16 + 12); rkv[ai][m] = 1.0f / sqrtf((q[0] + q[1] + q[2] + q[3]) * (1.0f / KVLORA) + EPS); }
        HD_SCHED_BARRIER();
        FOR_AI_M { const int tr = 128 * ai + 64 * wr + 16 * m + fr;
            FOR_BJ { float v[8]; acc8(acc, ai, bj, m, v); FOR_J8 v[j] *= rkv[ai][m];
                const int n = u.pn * 256 + 128 * bj + 32 * wc + 8 * fq, hh = n >> 7, j = n & 127; store8(O + (size_t)(u.row0 + tr) * KV_W + hh * 160 + (j < 64 ? j : j + 32), v); } }
    }
};
struct ProbBranch {
    static constexpr bool HAS_MID = true;
    static constexpr int ESZ = 2, EXA = 0, EXB = 0;
    GridPos g; const bf16_t* base; size_t offA, offB; const bf16_t* wa; const bf16_t* wb; const bf16_t* proj; bf16_t* M;
    HD int K() const { return 512; }
    HD const bf16_t* A() const { return base; }
    HD size_t arow(const Unit& u, int r) const { return (u.aux ? offB : offA) + (size_t)(u.row0 + r) * 512; }
    HD const bf16_t* B(const Unit& u) const { return (u.aux ? wb : wa) + (size_t)u.pn * 256 * 512; }
    HD bool next(int i, Unit& u) const { int pm, pn; if (!static_order(g, (long)(i >> 1) * g.G + g.c, NTOK / 256, 4, pm, pn)) return false; u.row0 = pm * 256; u.pn = pn; u.nrows = 256; u.aux = i & 1; return true; }
    HD bool is_mid(const Unit& u) const { return u.aux == 0; }
    HD void epi_mid(Acc& acc, const Unit& u, int wr, int wc, int fr, int fq) const {
        FOR_AI_M { const int tr = 128 * ai + 64 * wr + 16 * m + fr;
            FOR_BJ { const int col = u.pn * 256 + 128 * bj + 32 * wc + 8 * fq; float ga[8], gb[8];
                if (GATES_U8) { const unsigned char* g8 = (const unsigned char*)(proj + (size_t)(u.row0 + tr) * PROJ_W + PC_GA); load8_gate(g8 + col, ga); load8_gate(g8 + (PC_GB - PC_GA) + col, gb); }
                else { load8(proj + (size_t)(u.row0 + tr) * PROJ_W + PC_GA + col, ga); load8(proj + (size_t)(u.row0 + tr) * PROJ_W + PC_GB + col, gb); }
                FOR_J8 { const float r = ga[j] / fmaxf(gb[j], 1e-30f); if (j < 4) acc[ai][bj][m][0][j] *= r; else acc[ai][bj][m][1][j - 4] *= r; } } }
    }
    HD void epi(const Acc& acc, const Unit& u, int wr, int wc, int fr, int fq) const {
        FOR_AI_M { const int tr = 128 * ai + 64 * wr + 16 * m + fr;
            FOR_BJ { const int col = u.pn * 256 + 128 * bj + 32 * wc + 8 * fq; float v[8], gb[8]; acc8(acc, ai, bj, m, v);
                if (GATES_U8) load8_gate((const unsigned char*)(proj + (size_t)(u.row0 + tr) * PROJ_W + PC_GA) + (PC_GB - PC_GA) + col, gb);
                else load8(proj + (size_t)(u.row0 + tr) * PROJ_W + PC_GB + col, gb);
                FOR_J8 v[j] *= fmaxf(gb[j], 1e-30f);
                store8(M + (size_t)(u.row0 + tr) * 1024 + col, v); } }
    }
};
struct ProbOut {
    static constexpr bool HAS_MID = false;
    static constexpr int ESZ = 2, EXA = 0, EXB = 0;
    GridPos g; const bf16_t* M; const bf16_t* wt; const float* x; bf16_t* hb;
    HD int K() const { return 1024; }
    HD const bf16_t* A() const { return M; }
    HD size_t arow(const Unit& u, int r) const { return (size_t)(u.row0 + r) * 1024; }
    HD const bf16_t* B(const Unit& u) const { return wt + (size_t)u.pn * 256 * 1024; }
    HD bool next(int i, Unit& u) const { int pm, pn; if (!static_order(g, (long)i * g.G + g.c, NTOK / 256, 4, pm, pn)) return false; u.row0 = pm * 256; u.pn = pn; u.nrows = 256; u.aux = 0; return true; }
    HD void epi(const Acc& acc, const Unit& u, int wr, int wc, int fr, int fq) const {
        FOR_AI_M { const int tr = 128 * ai + 64 * wr + 16 * m + fr;
            FOR_BJ { const size_t off = (size_t)(u.row0 + tr) * 1024 + u.pn * 256 + 128 * bj + 32 * wc + 8 * fq;
                const f32x4 x0 = *(const f32x4*)(x + off) + acc[ai][bj][m][0], x1 = *(const f32x4*)(x + off + 4) + acc[ai][bj][m][1];
                const float v[8] = {x0[0], x0[1], x0[2], x0[3], x1[0], x1[1], x1[2], x1[3]}; store8(hb + off, v); } }
    }
};
struct ProbMoe1 {
    static constexpr bool HAS_MID = false;
    static constexpr int ESZ = 1, EXA = EXP_T, EXB = EXP_W;
    GridPos g; const unsigned char* T; const unsigned char* w1t; const float* b1; const int* tokof; const int* tiles; const int* ntiles; unsigned char* ACT; const float* rsof;
    HD int K() const { return 1024; }
    HD const unsigned char* A() const { return T; }
    HD size_t arow(const Unit& u, int r) const { const int rr = r < u.nrows ? r : u.nrows - 1; return (size_t)tokof[u.row0 + rr] * 1024; }
    HD const unsigned char* B(const Unit& u) const { return w1t + ((size_t)u.aux * 2048 + (size_t)u.pn * 256) * 1024; }
    HD bool next(int i, Unit& u) const { int t, pn; if (!static_order(g, (long)i * g.G + g.c, *ntiles, 8, t, pn)) return false; const int* tl = tiles + (size_t)t * 4; u.aux = tl[0]; u.row0 = tl[1]; u.nrows = tl[2]; u.pn = pn; return true; }
    HD void epi(const Acc& acc, const Unit& u, int wr, int wc, int fr, int fq) const {
        const int cj = u.pn * 128 + 32 * wc + 8 * fq;
        const float* bg = b1 + (size_t)u.aux * 2048 + cj; const float* bl = bg + 1024;
#if defined(__HIP_DEVICE_COMPILE__)
        _Pragma("unroll") for (int ai = 0; ai < 2; ++ai) _Pragma("unroll") for (int mp = 0; mp < 4; mp += 2) { unsigned px[2], py[2];
            _Pragma("unroll") for (int d = 0; d < 2; ++d) { const int m = mp + d; const int tr = 128 * ai + 64 * wr + 16 * m + fr; const int trc = tr < u.nrows ? tr : 0;
                float gl[8], li[8], a[8]; acc8(acc, ai, 0, m, gl); acc8(acc, ai, 1, m, li); const float rsv = rsof[u.row0 + trc];
                FOR_J8 { const float gv = fminf(gl[j] * rsv + bg[j], 7.0f); const float lv = fminf(fmaxf(li[j] * rsv + bl[j], -7.0f), 7.0f); a[j] = gv * sigmoidf_(1.702f * gv) * (lv + 1.0f) * (float)(1 << EXP_ACT); }
                px[d] = pk4_e4m3(a[0], a[1], a[2], a[3]); py[d] = pk4_e4m3(a[4], a[5], a[6], a[7]); }
            const auto sx = __builtin_amdgcn_permlane16_swap(px[0], px[1], false, false); const auto sy = __builtin_amdgcn_permlane16_swap(py[0], py[1], false, false);
            const int tr = 128 * ai + 64 * wr + 16 * (mp + (fq & 1)) + fr;
            if (tr < u.nrows) *(u32x4*)(ACT + (size_t)(u.row0 + tr) * 1024 + u.pn * 128 + 32 * wc + 8 * (fq & ~1)) = (u32x4){sx[0], sy[0], sx[1], sy[1]}; }
#else
        FOR_AI_M { const int tr = 128 * ai + 64 * wr + 16 * m + fr;
            if (tr < u.nrows) { float gl[8], li[8], a[8]; acc8(acc, ai, 0, m, gl); acc8(acc, ai, 1, m, li); const float rsv = rsof[u.row0 + tr];
                FOR_J8 { const float gv = fminf(gl[j] * rsv + bg[j], 7.0f); const float lv = fminf(fmaxf(li[j] * rsv + bl[j], -7.0f), 7.0f); a[j] = gv * sigmoidf_(1.702f * gv) * (lv + 1.0f); }
                store8_e4m3(ACT + (size_t)(u.row0 + tr) * 1024 + cj, a, (float)(1 << EXP_ACT)); } }
#endif
    }
};
struct ProbMoe2 {
    static constexpr bool HAS_MID = false;
    static constexpr int ESZ = 1, EXA = EXP_ACT, EXB = EXP_W;
    GridPos g; const unsigned char* ACT; const unsigned char* w2t; const float* b2; const float* wof; const int* tiles; const int* ntiles; unsigned char* Y;
    HD int K() const { return 1024; }
    HD const unsigned char* A() const { return ACT; }
    HD size_t arow(const Unit& u, int r) const { return (size_t)(u.row0 + r) * 1024; }
    HD const unsigned char* B(const Unit& u) const { return w2t + ((size_t)u.aux * 1024 + (size_t)u.pn * 256) * 1024; }
    HD bool next(int i, Unit& u) const { int t, pn; if (!static_order(g, (long)i * g.G + g.c, *ntiles, 4, t, pn)) return false; const int* tl = tiles + (size_t)t * 4; u.aux = tl[0]; u.row0 = tl[1]; u.nrows = tl[2]; u.pn = pn; return true; }
    HD void epi(const Acc& acc, const Unit& u, int wr, int wc, int fr, int fq) const {
#if defined(__HIP_DEVICE_COMPILE__)
        _Pragma("unroll") for (int ai = 0; ai < 2; ++ai) _Pragma("unroll") for (int mp = 0; mp < 4; mp += 2) { unsigned px[2][2], py[2][2];
            _Pragma("unroll") for (int d = 0; d < 2; ++d) { const int m = mp + d; const int tr = 128 * ai + 64 * wr + 16 * m + fr; const int trc = tr < u.nrows ? tr : 0; const float w = wof[u.row0 + trc] * (float)(1 << EXP_Y);
                FOR_BJ { const int col = u.pn * 256 + 128 * bj + 32 * wc + 8 * fq; float v[8]; acc8(acc, ai, bj, m, v); const float* bb = b2 + (size_t)u.aux * 1024 + col;
                    FOR_J8 v[j] = w * (v[j] + bb[j]);
                    px[bj][d] = pk4_e4m3(v[0], v[1], v[2], v[3]); py[bj][d] = pk4_e4m3(v[4], v[5], v[6], v[7]); } }
            const int tr = 128 * ai + 64 * wr + 16 * (mp + (fq & 1)) + fr;
            FOR_BJ { const auto sx = __builtin_amdgcn_permlane16_swap(px[bj][0], px[bj][1], false, false); const auto sy = __builtin_amdgcn_permlane16_swap(py[bj][0], py[bj][1], false, false);
                if (tr < u.nrows) *(u32x4*)(Y + (size_t)(u.row0 + tr) * 1024 + u.pn * 256 + 128 * bj + 32 * wc + 8 * (fq & ~1)) = (u32x4){sx[0], sy[0], sx[1], sy[1]}; } }
#else
        FOR_AI_M { const int tr = 128 * ai + 64 * wr + 16 * m + fr;
            if (tr < u.nrows) { const float w = wof[u.row0 + tr];
                FOR_BJ { const int col = u.pn * 256 + 128 * bj + 32 * wc + 8 * fq; float v[8]; acc8(acc, ai, bj, m, v); const float* bb = b2 + (size_t)u.aux * 1024 + col;
                    FOR_J8 v[j] = w * (v[j] + bb[j]);
                    store8_e4m3(Y + (size_t)(u.row0 + tr) * 1024 + col, v, (float)(1 << EXP_Y)); } } }
#endif
    }
};

HD void ld4(const bf16_t* p, float* v) { const unsigned long long w = *(const unsigned long long*)p;
    v[0] = __builtin_bit_cast(float, (unsigned)(w << 16)); v[1] = __builtin_bit_cast(float, (unsigned)w & 0xffff0000u);
    v[2] = __builtin_bit_cast(float, (unsigned)(w >> 32) << 16); v[3] = __builtin_bit_cast(float, (unsigned)(w >> 32) & 0xffff0000u); }
HD void ld4(const unsigned char* p, float* v) { const unsigned w = *(const unsigned*)p; v[0] = e4m32f((unsigned char)w); v[1] = e4m32f((unsigned char)(w >> 8)); v[2] = e4m32f((unsigned char)(w >> 16)); v[3] = e4m32f((unsigned char)(w >> 24)); }
template <class P> HD void ref_gemm_thread(const P& p, const Unit& u, int tid, Acc& acc, bool keep = false) {
    const int wid = tid >> 6, lane = tid & 63, wr = wid >> 2, wc = wid & 3, fr = lane & 15, fq = lane >> 4;
    const int K = p.K(); const auto* A = p.A(); const auto* B = p.B(u);
#pragma unroll
    for (int ai = 0; ai < 2; ++ai) {
        if (!keep) {
#pragma unroll
        for (int bj = 0; bj < 2; ++bj)
#pragma unroll
            for (int m = 0; m < 4; ++m)
#pragma unroll
                for (int n = 0; n < 2; ++n) acc[ai][bj][m][n] = (f32x4){0.f, 0.f, 0.f, 0.f}; }
        size_t ao[4]; bool valid[4];
#pragma unroll
        for (int m = 0; m < 4; ++m) { const int tr = 128 * ai + 64 * wr + 16 * m + fr; valid[m] = tr < u.nrows; ao[m] = p.arow(u, tr); }
#pragma unroll 1
        for (int k0 = 0; k0 < K; k0 += 4) {
            float a[4][4];
#pragma unroll
            for (int m = 0; m < 4; ++m) { if (valid[m]) ld4(A + ao[m] + k0, a[m]); else { a[m][0] = a[m][1] = a[m][2] = a[m][3] = 0.f; } }
#pragma unroll
            for (int bj = 0; bj < 2; ++bj)
#pragma unroll
                for (int n = 0; n < 2; ++n)
#pragma unroll
                    for (int r = 0; r < 4; ++r) {
                        const int col = 128 * bj + 32 * wc + 8 * fq + 4 * n + r; float b[4]; ld4(B + (size_t)col * K + k0, b);
#pragma unroll
                        for (int m = 0; m < 4; ++m) acc[ai][bj][m][n][r] += a[m][0] * b[0] + a[m][1] * b[1] + a[m][2] * b[2] + a[m][3] * b[3];
                    }
        }
        if (P::EXA + P::EXB != 0) { const float sc = 1.0f / (float)(1 << (P::EXA + P::EXB));
#pragma unroll
            for (int bj = 0; bj < 2; ++bj)
#pragma unroll
                for (int m = 0; m < 4; ++m)
#pragma unroll
                    for (int n = 0; n < 2; ++n) acc[ai][bj][m][n] *= sc; }
    }
}

template <int DQK, int DV> HD void ref_attn_row(const bf16_t* q, const bf16_t* k0, int ldk, const bf16_t* v0, int ldv, bf16_t* o, int qpos, float scale) {
    float qf[DQK], of[DV];
#pragma unroll
    for (int c = 0; c < DQK; c += 8) load8(q + c, qf + c);
#pragma unroll
    for (int d = 0; d < DV; ++d) of[d] = 0.f;
    float mx = -INFINITY, l = 0.f;
    for (int j = 0; j <= qpos; ++j) {
        const bf16_t* kr = k0 + (size_t)j * ldk; float s = 0.f;
#pragma unroll
        for (int c = 0; c < DQK; c += 8) { float kf[8]; load8(kr + c, kf);
#pragma unroll
            for (int t = 0; t < 8; ++t) s += qf[c + t] * kf[t]; }
        s *= scale;
        if (s > mx) { const float al = expf(mx - s); l *= al;
#pragma unroll
            for (int d = 0; d < DV; ++d) of[d] *= al;
            mx = s; }
        const float pj = expf(s - mx); l += pj;
        const bf16_t* vr = v0 + (size_t)j * ldv;
#pragma unroll
        for (int c = 0; c < DV; c += 8) { float vf[8]; load8(vr + c, vf);
#pragma unroll
            for (int t = 0; t < 8; ++t) of[c + t] += pj * vf[t]; }
    }
    const float il = 1.0f / l;
#pragma unroll
    for (int d = 0; d < DV; ++d) of[d] *= il;
#pragma unroll
    for (int c = 0; c < DV; c += 8) store8(o + c, of + c);
}
struct AttnMla { const bf16_t* QA; const bf16_t* KV; bf16_t* OA; };
HD void ref_attn_mla_item(const Params& p, long item) {
    const int pos = (int)(item % SEQ), h = (int)((item / SEQ) & 7), b = (int)(item / SEQ / 8); const size_t tok0 = (size_t)b * SEQ;
    ref_attn_row<96, 64>(wsp<bf16_t>(p, WS_QA) + (tok0 + pos) * QA_W + h * 96, wsp<bf16_t>(p, WS_KV) + tok0 * KV_W + h * 160, KV_W,
                         wsp<bf16_t>(p, WS_KV) + tok0 * KV_W + h * 160 + 96, KV_W, wsp<bf16_t>(p, WS_OA) + (tok0 + pos) * 512 + h * 64, pos, LN2);
}
HD void ref_attn_diff_item(const Params& p, long item) {
    const int pos = (int)(item % SEQ), h = (int)((item / SEQ) & 7), b = (int)(item / SEQ / 8); const size_t tok0 = (size_t)b * SEQ;
    const bf16_t* proj = wsp<bf16_t>(p, WS_PROJ);
    ref_attn_row<64, 128>(proj + (tok0 + pos) * PROJ_W + PC_DQ + h * 64, proj + tok0 * PROJ_W + PC_DK + h * 64, PROJ_W,
                          proj + tok0 * PROJ_W + PC_DV + (h >> 1) * 128, PROJ_W, wsp<bf16_t>(p, WS_OD) + (tok0 + pos) * OD_W + h * 128, pos, LN2);
}

HD ProbInProj mk_inproj(const Params& p, GridPos g) { return ProbInProj{g, wsp<ProbInProj::el_t>(p, WS_XN), wsp<ProbInProj::el_t>(p, WS_WIN), wsp<bf16_t>(p, WS_PROJ), wsp<float>(p, WS_SSP)}; }
HD ProbInProjG mk_inprojg(const Params& p, GridPos g) { return ProbInProjG{g, wsp<unsigned char>(p, WS_XN8), wsp<unsigned char>(p, WS_WIN8), wsp<bf16_t>(p, WS_PROJ)}; }
HD ProbUpQ mk_upq(const Params& p, GridPos g) { return ProbUpQ{g, wsp<bf16_t>(p, WS_PROJ), wsp<bf16_t>(p, WS_WUQ), wsp<bf16_t>(p, WS_QA)}; }
HD ProbUpKV mk_upkv(const Params& p, GridPos g) { return ProbUpKV{g, wsp<bf16_t>(p, WS_PROJ), wsp<bf16_t>(p, WS_WUKV), wsp<bf16_t>(p, WS_KV), wsp<float>(p, WS_SSP)}; }
HD ProbBranch mk_branch(const Params& p, GridPos g) { constexpr size_t lo = WS_OA < WS_OB ? WS_OA : WS_OB; return ProbBranch{g, wsp<bf16_t>(p, lo), (WS_OA - lo) / 2, (WS_OB - lo) / 2, wsp<bf16_t>(p, WS_WBA), wsp<bf16_t>(p, WS_WBB), wsp<bf16_t>(p, WS_PROJ), wsp<bf16_t>(p, WS_MERGED)}; }
HD ProbOut mk_out(const Params& p, GridPos g) { return ProbOut{g, wsp<bf16_t>(p, WS_MERGED), wsp<bf16_t>(p, WS_WOUT), p.x, wsp<bf16_t>(p, WS_HB)}; }
HD ProbMoe1 mk_moe1(const Params& p, GridPos g, int hf) { return ProbMoe1{g, wsp<unsigned char>(p, WS_T), wsp<unsigned char>(p, WS_W1), p.b1, wsp<int>(p, WS_TOKOF) + (size_t)hf * HALF_SLOTS,
    wsp<int>(p, WS_MISC + MS_TILES) + (size_t)hf * MAX_TILES * 4, wsp<int>(p, WS_MISC + MS_NTILES) + hf, wsp<unsigned char>(p, WS_ACT), wsp<float>(p, WS_RSOF) + (size_t)hf * HALF_SLOTS}; }
HD ProbMoe2 mk_moe2(const Params& p, GridPos g, int hf) { return ProbMoe2{g, wsp<unsigned char>(p, WS_ACT), wsp<unsigned char>(p, WS_W2), p.b2, wsp<float>(p, WS_WOF) + (size_t)hf * HALF_SLOTS,
    wsp<int>(p, WS_MISC + MS_TILES) + (size_t)hf * MAX_TILES * 4, wsp<int>(p, WS_MISC + MS_NTILES) + hf, wsp<unsigned char>(p, WS_Y)}; }


#define LAS __attribute__((address_space(3)))
constexpr int NWAVES = 8, NTHREADS = NWAVES * 64;
constexpr int RING_BYTES = 131072;
constexpr int MISC_OFF = RING_BYTES + 320;
constexpr int LDS_BYTES = 147456;

#define XB_TMO      128
#define XB_XCNT(j)  (256  + 64 * (j))
#define XB_XSUB(j)  (1280 + 64 * (j))
#define XB_XGEN(j)  (2304 + 64 * (j))
#define XB_TOP      3328
#define XB_TOPGEN   3392
#define XCD_BAR_WORDS 3456
#define XB_SPIN_CAP (1u << 22)
__device__ __forceinline__ unsigned xb_ld(unsigned* p)              { return __hip_atomic_load(p, __ATOMIC_RELAXED, __HIP_MEMORY_SCOPE_AGENT); }
__device__ __forceinline__ unsigned xb_add(unsigned* p, unsigned v) { return __hip_atomic_fetch_add(p, v, __ATOMIC_RELAXED, __HIP_MEMORY_SCOPE_AGENT); }
__device__ __forceinline__ unsigned xb_xcc_id() { return (unsigned)__builtin_amdgcn_s_getreg((3 << 11) | 20) & 0xFu; }
#define XB_SPIN(cond, bar) do { unsigned _sp = 0; while (cond) { __builtin_amdgcn_s_sleep(1); \
    if ((++_sp & 255u) == 0u) { if (xb_ld(&(bar)[XB_TMO])) break; if (_sp > XB_SPIN_CAP) { atomicAdd(&(bar)[XB_TMO], 1u); break; } } } } while (0)
struct XcdBarrier { unsigned* bar; unsigned x; volatile LAS unsigned* st; };
__device__ __forceinline__ XcdBarrier xcd_barrier_post(unsigned* bar, volatile LAS unsigned* st) {
    XcdBarrier b; b.bar = bar; b.x = xb_xcc_id(); b.st = st;
    if (threadIdx.x == 0) (void)xb_add(&bar[XB_XCNT(b.x)], 1u);
    return b;
}
__device__ __forceinline__ void xcd_barrier_complete(unsigned* bar, unsigned x, unsigned& nloc, unsigned& nx) {
    const unsigned G = gridDim.x * gridDim.y * gridDim.z;
    unsigned sum, cnt, mine, sp = 0u;
    for (;;) {
        sum = 0u; cnt = 0u; mine = 0u;
#pragma unroll
        for (unsigned j = 0; j < 16; ++j) { const unsigned c = xb_ld(&bar[XB_XCNT(j)]); sum += c; cnt += (c > 0u) ? 1u : 0u; mine = (j == x) ? c : mine; }
        if (sum == G) break;
        __builtin_amdgcn_s_sleep(1);
        if ((++sp & 255u) == 0u) { if (xb_ld(&bar[XB_TMO])) break; if (sp > XB_SPIN_CAP) { atomicAdd(&bar[XB_TMO], 1u); break; } }
    }
    nloc = mine > 0u ? mine : 1u; nx = cnt > 0u ? cnt : 1u;
}
__device__ __forceinline__ void xcd_barrier(const XcdBarrier& b) {
    asm volatile("s_waitcnt vmcnt(0)" ::: "memory");
    __syncthreads();
    if (threadIdx.x == 0) {
        unsigned* bar = b.bar;
        __builtin_amdgcn_s_waitcnt(0);
        unsigned nloc = b.st[0], nx = b.st[1];
        if (nloc == 0u) { xcd_barrier_complete(bar, b.x, nloc, nx); b.st[0] = nloc; b.st[1] = nx; }
        const unsigned old = xb_add(&bar[XB_XSUB(b.x)], 1u);
        const unsigned gen = old / nloc;
        if (old + 1u == (gen + 1u) * nloc) {
            __builtin_amdgcn_fence(__ATOMIC_RELEASE, "agent");
            asm volatile("s_waitcnt vmcnt(0)" ::: "memory");
            const unsigned og = xb_add(&bar[XB_TOP], 1u);
            const unsigned tg = og / nx;
            if (og + 1u == (tg + 1u) * nx) xb_add(&bar[XB_TOPGEN], 1u);
            else XB_SPIN(xb_ld(&bar[XB_TOPGEN]) == tg, bar);
            __builtin_amdgcn_fence(__ATOMIC_ACQUIRE, "agent");
            xb_add(&bar[XB_XGEN(b.x)], 1u);
            asm volatile("s_waitcnt vmcnt(0)" ::: "memory");
        } else {
            XB_SPIN(xb_ld(&bar[XB_XGEN(b.x)]) == gen, bar);
            __builtin_amdgcn_fence(__ATOMIC_ACQUIRE, "agent");
            asm volatile("s_waitcnt vmcnt(0)" ::: "memory");
        }
    }
    __syncthreads();
}

namespace pg8 {
typedef short bf16x8 __attribute__((ext_vector_type(8)));
constexpr int BK = 64, HALF = 128, HTB = HALF * BK * 2, STAGE_BYTES = 8 * HTB;
__device__ __forceinline__ int lds_byte(int r, int c) { const int ch = c >> 3, pc = r >> 3; return pc * 1024 + (ch >> 2) * 512 + (r & 7) * 64 + (((ch & 3) ^ ((pc & 1) << 1)) << 4); }
__device__ __forceinline__ void stage_rc(int b, int& R, int& C) { const int pc = b >> 10, j = (b >> 4) & 63, r = (j >> 2) & 7, ch = ((j >> 5) << 2) | ((j & 3) ^ ((pc & 1) << 1)); R = pc * 8 + r; C = ch * 8; }
__device__ __forceinline__ int perm32(int rho) { const int n = rho >> 4, i = rho & 15; return 8 * (i >> 2) + 4 * n + (i & 3); }

template <class P, int VAR = 0>
__device__ __forceinline__ void gemm_phase(LAS unsigned char* lds, const P& pr, const unsigned char* wsbase) {
    int tid_ = threadIdx.x; asm volatile("" : "+v"(tid_));
    const int tid = tid_, wid = __builtin_amdgcn_readfirstlane(tid >> 6), lane = tid & 63, wr = wid >> 2, wc = wid & 3, fr = lane & 15, fq = lane >> 4;
    constexpr int ESZ = P::ESZ;
    const int KB = pr.K() * ESZ, nt = KB / (BK * 2);
    int Rr[2], Cc[2]; unsigned voffB[2];
#pragma unroll
    for (int i = 0; i < 2; ++i) { int R, C; stage_rc(tid * 16 + i * 8192, R, C); Rr[i] = R; Cc[i] = C; const int Rb = (R & ~31) + perm32(R & 31); voffB[i] = (unsigned)(Rb * KB + C * 2); }
    const size_t kstep = (size_t)(BK * 2);
    const size_t hstepB = (size_t)HALF * KB;
    const unsigned ldsw = (unsigned)wid * 1024u;
    const int aoff = lds_byte(wr * 64 + fr, fq * 8), boff = lds_byte(wc * 32 + fr, fq * 8);
    const __amdgpu_buffer_rsrc_t rsrc = __builtin_amdgcn_make_buffer_rsrc((void*)wsbase, 0, 0xffffffffu, 0x00020000);
    const unsigned Aoff = (unsigned)((const unsigned char*)pr.A() - wsbase);
    typedef int v4i_t __attribute__((ext_vector_type(4))); typedef int v8i_t __attribute__((ext_vector_type(8)));
    const int scale_w = (127 - P::EXB) * 0x01010101, scale_x = (127 - P::EXA) * 0x01010101;
#define PG8_SA(b, h) (((b) * 2 + (h)) * HTB)
#define PG8_SB(b, h) ((4 + (b) * 2 + (h)) * HTB)
#define PG8_STAGE_A(bufoff, offs, kb) do { if constexpr (VAR != 3) _Pragma("unroll") for (int _i = 0; _i < 2; ++_i) \
        __builtin_amdgcn_raw_ptr_buffer_load_lds(rsrc, (LAS unsigned*)(lds + (bufoff) + ldsw + _i * 8192), 16, (offs)[_i], Aoff + (unsigned)(kb), 0, 0); } while (0)
#define PG8_STAGE_B(bufoff, gbase) do { if constexpr (VAR != 3) _Pragma("unroll") for (int _i = 0; _i < 2; ++_i) \
        __builtin_amdgcn_raw_ptr_buffer_load_lds(rsrc, (LAS unsigned*)(lds + (bufoff) + ldsw + _i * 8192), 16, voffB[_i], (unsigned)(gbase), 0, 0); } while (0)
#define PG8_LDA(dst, b, h) do { if constexpr (VAR == 2) { } else if constexpr (ESZ == 2) { _Pragma("unroll") for (int m = 0; m < 4; ++m) _Pragma("unroll") for (int k = 0; k < 2; ++k) dst[m][k] = *(const LAS bf16x8*)(lds + PG8_SA(b, h) + aoff + m * 2048 + k * 512); } \
        else { _Pragma("unroll") for (int m = 0; m < 4; ++m) { const v4i_t _lo = *(const LAS v4i_t*)(lds + PG8_SA(b, h) + aoff + m * 2048), _hi = *(const LAS v4i_t*)(lds + PG8_SA(b, h) + aoff + m * 2048 + 512); \
            dst##8[m] = __builtin_shufflevector(_lo, _hi, 0, 1, 2, 3, 4, 5, 6, 7); } } } while (0)
#define PG8_LDB(dst, b, h) do { if constexpr (VAR == 2) { } else if constexpr (ESZ == 2) { _Pragma("unroll") for (int n = 0; n < 2; ++n) _Pragma("unroll") for (int k = 0; k < 2; ++k) dst[n][k] = *(const LAS bf16x8*)(lds + PG8_SB(b, h) + boff + n * 2048 + k * 512); } \
        else { _Pragma("unroll") for (int n = 0; n < 2; ++n) { const v4i_t _lo = *(const LAS v4i_t*)(lds + PG8_SB(b, h) + boff + n * 2048), _hi = *(const LAS v4i_t*)(lds + PG8_SB(b, h) + boff + n * 2048 + 512); \
            dst##8[n] = __builtin_shufflevector(_lo, _hi, 0, 1, 2, 3, 4, 5, 6, 7); } } } while (0)
#define PG8_MMA(ai, bj, At, Bt) do { if constexpr (VAR != 4) __builtin_amdgcn_s_setprio(1); \
        if constexpr (VAR == 6) { __builtin_amdgcn_s_sleep(8); } \
        if constexpr (VAR == 1 || VAR == 6) { _Pragma("unroll") for (int m = 0; m < 4; ++m) _Pragma("unroll") for (int k = 0; k < 2; ++k) asm volatile("" :: "v"(At[m][k])); _Pragma("unroll") for (int n = 0; n < 2; ++n) _Pragma("unroll") for (int k = 0; k < 2; ++k) asm volatile("" :: "v"(Bt[n][k])); } \
        else if constexpr (ESZ == 2) { _Pragma("unroll") for (int m = 0; m < 4; ++m) _Pragma("unroll") for (int n = 0; n < 2; ++n) _Pragma("unroll") for (int k = 0; k < 2; ++k) \
            acc[ai][bj][m][n] = __builtin_amdgcn_mfma_f32_16x16x32_bf16(Bt[n][k], At[m][k], acc[ai][bj][m][n], 0, 0, 0); } \
        else { _Pragma("unroll") for (int m = 0; m < 4; ++m) _Pragma("unroll") for (int n = 0; n < 2; ++n) \
            asm volatile("v_mfma_scale_f32_16x16x128_f8f6f4 %0, %1, %2, %0, %3, %4 op_sel_hi:[0,0,0]" : "+v"(acc[ai][bj][m][n]) : "v"(Bt##8[n]), "v"(At##8[m]), "v"(scale_w), "v"(scale_x)); } \
        if constexpr (VAR != 4) __builtin_amdgcn_s_setprio(0); } while (0)
#define PG8_WAIT_V(n) asm volatile("s_waitcnt vmcnt(" #n ")" ::: "memory")
#define PG8_WAIT_L(n) asm volatile("s_waitcnt lgkmcnt(" #n ")" ::: "memory")
#define PG8_BAR do { if constexpr (VAR != 5) __builtin_amdgcn_s_barrier(); } while (0)
#define PG8_SCHED __builtin_amdgcn_sched_barrier(0)
#define PG8_FILL(u, o) do { _Pragma("unroll") for (int _h = 0; _h < 2; ++_h) _Pragma("unroll") for (int _i = 0; _i < 2; ++_i) (o)[_h][_i] = (unsigned)(pr.arow((u), _h * HALF + Rr[_i]) * ESZ + (size_t)Cc[_i] * 2); } while (0)
    Unit cur, nxt; int ui = 0;
    if (!pr.next(0, cur)) return;
    Acc acc;
#pragma unroll
    for (int a = 0; a < 2; ++a)
#pragma unroll
        for (int b = 0; b < 2; ++b)
#pragma unroll
            for (int m = 0; m < 4; ++m)
#pragma unroll
                for (int n = 0; n < 2; ++n) acc[a][b][m][n] = (f32x4){0.f, 0.f, 0.f, 0.f};
    bf16x8 At[4][2] = {}, B0[2][2] = {}, B1[2][2] = {}; v8i_t At8[4] = {}, B08[2] = {}, B18[2] = {};
    unsigned curA[2][2], nxtA[2][2];
    PG8_FILL(cur, curA);
    unsigned cB = (unsigned)((const unsigned char*)pr.B(cur) - wsbase);
    PG8_STAGE_B(PG8_SB(0, 0), cB); PG8_STAGE_B(PG8_SB(0, 1), cB + (unsigned)hstepB); PG8_STAGE_A(PG8_SA(0, 0), curA[0], 0); PG8_STAGE_A(PG8_SA(0, 1), curA[1], 0);
    if (wr == 1 && VAR != 7) PG8_BAR;
    PG8_WAIT_V(2); PG8_BAR;
    PG8_STAGE_B(PG8_SB(1, 0), cB + (unsigned)kstep); PG8_STAGE_A(PG8_SA(1, 0), curA[0], kstep); PG8_STAGE_B(PG8_SB(1, 1), cB + (unsigned)(hstepB + kstep));
    PG8_WAIT_V(6); PG8_BAR;
    for (;;) {
        const bool has_next = pr.next(ui + 1, nxt);
        unsigned nB = cB;
        if (has_next) { PG8_FILL(nxt, nxtA); nB = (unsigned)((const unsigned char*)pr.B(nxt) - wsbase); }
        else {
#pragma unroll
            for (int h = 0; h < 2; ++h)
#pragma unroll
                for (int i = 0; i < 2; ++i) nxtA[h][i] = curA[h][i]; }
#pragma unroll 1
        for (int t = 0; t < nt; t += 2) {
            const bool last = (t == nt - 2);
            const size_t k1 = (size_t)(t + 1) * kstep;
            const size_t k2 = last ? 0 : (size_t)(t + 2) * kstep, k3 = k2 + kstep;
            unsigned a2o[2][2];
#pragma unroll
            for (int h = 0; h < 2; ++h)
#pragma unroll
                for (int i = 0; i < 2; ++i) a2o[h][i] = last ? nxtA[h][i] : curA[h][i];
            const unsigned b2 = last ? nB : cB + (unsigned)((size_t)(t + 2) * kstep), b3 = b2 + (unsigned)kstep;
            PG8_LDB(B0, 0, 0); PG8_LDB(B1, 0, 1); PG8_SCHED; PG8_LDA(At, 0, 0); PG8_STAGE_A(PG8_SA(1, 1), curA[1], k1);
            PG8_WAIT_V(8); PG8_WAIT_L(0); PG8_BAR; PG8_MMA(0, 0, At, B0); PG8_MMA(0, 1, At, B1); PG8_BAR; PG8_SCHED;
            PG8_LDA(At, 0, 1); PG8_STAGE_B(PG8_SB(0, 0), b2); PG8_STAGE_B(PG8_SB(0, 1), b2 + (unsigned)hstepB); PG8_STAGE_A(PG8_SA(0, 0), a2o[0], k2);
            PG8_WAIT_V(8); PG8_WAIT_L(0); PG8_BAR; PG8_MMA(1, 0, At, B0); PG8_MMA(1, 1, At, B1); PG8_BAR; PG8_SCHED;
            PG8_LDB(B0, 1, 0); PG8_LDB(B1, 1, 1); PG8_SCHED; PG8_LDA(At, 1, 0); PG8_STAGE_A(PG8_SA(0, 1), a2o[1], k2);
            PG8_WAIT_V(8); PG8_WAIT_L(0); PG8_BAR; PG8_MMA(0, 0, At, B0); PG8_MMA(0, 1, At, B1); PG8_BAR; PG8_SCHED;
            PG8_LDA(At, 1, 1); PG8_STAGE_B(PG8_SB(1, 0), b3); PG8_STAGE_B(PG8_SB(1, 1), b3 + (unsigned)hstepB); PG8_STAGE_A(PG8_SA(1, 0), a2o[0], k3);
            PG8_WAIT_V(8); PG8_WAIT_L(0); PG8_BAR; PG8_MMA(1, 0, At, B0); PG8_MMA(1, 1, At, B1); PG8_BAR; PG8_SCHED;
        }
        if (wr == 0 && VAR != 7) PG8_BAR;
        bool mid = false;
        if constexpr (P::HAS_MID) { mid = pr.is_mid(cur); if (mid) pr.epi_mid(acc, cur, wr, wc, fr, fq); else pr.epi(acc, cur, wr, wc, fr, fq); } else pr.epi(acc, cur, wr, wc, fr, fq);
        if (!has_next) break;
        if (!mid)
#pragma unroll
        for (int a = 0; a < 2; ++a)
#pragma unroll
            for (int b = 0; b < 2; ++b)
#pragma unroll
                for (int m = 0; m < 4; ++m)
#pragma unroll
                    for (int n = 0; n < 2; ++n) acc[a][b][m][n] = (f32x4){0.f, 0.f, 0.f, 0.f};
        cur = nxt; cB = nB; ++ui;
#pragma unroll
        for (int h = 0; h < 2; ++h)
#pragma unroll
            for (int i = 0; i < 2; ++i) curA[h][i] = nxtA[h][i];
        if (wr == 1 && VAR != 7) PG8_BAR;
    }
    PG8_WAIT_V(0);
    PG8_BAR;
#undef PG8_SA
#undef PG8_SB
#undef PG8_STAGE_A
#undef PG8_STAGE_B
#undef PG8_LDA
#undef PG8_LDB
#undef PG8_MMA
#undef PG8_WAIT_V
#undef PG8_WAIT_L
#undef PG8_BAR
#undef PG8_SCHED
#undef PG8_FILL
}

template <class P, int VAR = 0>
__device__ __forceinline__ void gemm_phase_pipe(LAS unsigned char* lds, const P& pr, const unsigned char* wsbase) {
    static_assert(P::ESZ == 2, "bf16 operands");
    int tid_ = threadIdx.x; asm volatile("" : "+v"(tid_));
    const int tid = tid_, wid = __builtin_amdgcn_readfirstlane(tid >> 6), lane = tid & 63, wr = wid >> 2, wc = wid & 3, fr = lane & 15, fq = lane >> 4;
    const int KB = pr.K() * 2, nt = KB / 128;
    int Rr[2], Cc[2]; unsigned voffB[2];
#pragma unroll
    for (int i = 0; i < 2; ++i) { int R, C; stage_rc(tid * 16 + i * 8192, R, C); Rr[i] = R; Cc[i] = C; const int Rb = (R & ~31) + perm32(R & 31); voffB[i] = (unsigned)(Rb * KB + C * 2); }
    const unsigned hstepB = (unsigned)(HALF * KB);
    const unsigned ldsw = (unsigned)wid * 1024u;
    const int aoff = lds_byte(wr * 64 + fr, fq * 8), boff = lds_byte(wc * 32 + fr, fq * 8);
    const __amdgpu_buffer_rsrc_t rsrc = __builtin_amdgcn_make_buffer_rsrc((void*)wsbase, 0, 0xffffffffu, 0x00020000);
    const unsigned Aoff = (unsigned)((const unsigned char*)pr.A() - wsbase);
#define PP_SA(b, h) (((b) * 2 + (h)) * HTB)
#define PP_SB(b, h) ((4 + (b) * 2 + (h)) * HTB)
#define PP_DMA(ldsoff, voff, soff) __builtin_amdgcn_raw_ptr_buffer_load_lds(rsrc, (LAS unsigned*)(lds + (ldsoff) + ldsw), 16, (voff), (soff), 0, 0)
#define PP_STAGE(b, ao, kb, bb) do { _Pragma("unroll") for (int _h = 0; _h < 2; ++_h) _Pragma("unroll") for (int _i = 0; _i < 2; ++_i) { \
        PP_DMA(PP_SA(b, _h) + _i * 8192, (ao)[_h][_i], Aoff + (unsigned)(kb)); PP_DMA(PP_SB(b, _h) + _i * 8192, voffB[_i], (bb) + (unsigned)(kb) + _h * hstepB); } } while (0)
#define PP_LDA(dst, b, ai, k) do { if constexpr (VAR != 2) _Pragma("unroll") for (int m = 0; m < 4; ++m) dst[m] = *(const LAS bf16x8*)(lds + PP_SA(b, ai) + aoff + m * 2048 + (k) * 512); } while (0)
#define PP_LDB(dst, b, k) do { if constexpr (VAR != 2) _Pragma("unroll") for (int bj = 0; bj < 2; ++bj) _Pragma("unroll") for (int n = 0; n < 2; ++n) dst[bj][n] = *(const LAS bf16x8*)(lds + PP_SB(b, bj) + boff + n * 2048 + (k) * 512); } while (0)
#define PP_MMA(ai, Af, Bf) do { if constexpr (VAR == 1) { _Pragma("unroll") for (int m = 0; m < 4; ++m) asm volatile("" :: "v"(Af[m])); _Pragma("unroll") for (int bj = 0; bj < 2; ++bj) _Pragma("unroll") for (int n = 0; n < 2; ++n) asm volatile("" :: "v"(Bf[bj][n])); } \
        else _Pragma("unroll") for (int m = 0; m < 4; ++m) _Pragma("unroll") for (int bj = 0; bj < 2; ++bj) _Pragma("unroll") for (int n = 0; n < 2; ++n) \
        acc[ai][bj][m][n] = __builtin_amdgcn_mfma_f32_16x16x32_bf16(Bf[bj][n], Af[m], acc[ai][bj][m][n], 0, 0, 0); } while (0)
#define PP_FILL(u, o) do { _Pragma("unroll") for (int _h = 0; _h < 2; ++_h) _Pragma("unroll") for (int _i = 0; _i < 2; ++_i) (o)[_h][_i] = (unsigned)(pr.arow((u), _h * HALF + Rr[_i]) * 2 + (size_t)Cc[_i] * 2); } while (0)
#define PP_SCHED __builtin_amdgcn_sched_barrier(0)
    Unit cur, nxt; int ui = 0;
    if (!pr.next(0, cur)) return;
    Acc acc;
#pragma unroll
    for (int a = 0; a < 2; ++a)
#pragma unroll
        for (int b = 0; b < 2; ++b)
#pragma unroll
            for (int m = 0; m < 4; ++m)
#pragma unroll
                for (int n = 0; n < 2; ++n) acc[a][b][m][n] = (f32x4){0.f, 0.f, 0.f, 0.f};
    bf16x8 Ax[4] = {}, Ay[4] = {}, Bx[2][2] = {}, By[2][2] = {};
    unsigned curA[2][2], nxtA[2][2];
    PP_FILL(cur, curA);
    unsigned cB = (unsigned)((const unsigned char*)pr.B(cur) - wsbase);
    PP_STAGE(0, curA, 0, cB); PP_STAGE(1, curA, 128, cB);
    asm volatile("s_waitcnt vmcnt(8)" ::: "memory"); __builtin_amdgcn_s_barrier();
    PP_LDA(Ax, 0, 0, 0); PP_LDB(Bx, 0, 0);
    for (;;) {
        const bool has_next = pr.next(ui + 1, nxt);
        unsigned nB = cB;
        if (has_next) { PP_FILL(nxt, nxtA); nB = (unsigned)((const unsigned char*)pr.B(nxt) - wsbase); }
        else {
#pragma unroll
            for (int h = 0; h < 2; ++h)
#pragma unroll
                for (int i = 0; i < 2; ++i) nxtA[h][i] = curA[h][i]; }
#pragma unroll 1
        for (int t = 0; t < nt; t += 2) {
            { const bool wrap = (t + 2 >= nt); const unsigned kb2 = wrap ? (unsigned)(t + 2 - nt) * 128u : (unsigned)(t + 2) * 128u; const unsigned b2 = wrap ? nB : cB;
              unsigned a2o[2][2];
#pragma unroll
              for (int h = 0; h < 2; ++h)
#pragma unroll
                  for (int i = 0; i < 2; ++i) a2o[h][i] = wrap ? nxtA[h][i] : curA[h][i];
              PP_LDA(Ay, 0, 1, 0); PP_MMA(0, Ax, Bx); PP_SCHED;
              PP_LDA(Ax, 0, 0, 1); PP_LDB(By, 0, 1); PP_MMA(1, Ay, Bx); PP_SCHED;
              PP_LDA(Ay, 0, 1, 1); PP_MMA(0, Ax, By); PP_SCHED;
              asm volatile("s_waitcnt vmcnt(0) lgkmcnt(0)" ::: "memory"); __builtin_amdgcn_s_barrier();
              PP_STAGE(0, a2o, kb2, b2);
              PP_LDA(Ax, 1, 0, 0); PP_LDB(Bx, 1, 0); PP_MMA(1, Ay, By); PP_SCHED; }
            { const bool wrap = (t + 3 >= nt); const unsigned kb3 = wrap ? (unsigned)(t + 3 - nt) * 128u : (unsigned)(t + 3) * 128u; const unsigned b3 = wrap ? nB : cB;
              unsigned a3o[2][2];
#pragma unroll
              for (int h = 0; h < 2; ++h)
#pragma unroll
                  for (int i = 0; i < 2; ++i) a3o[h][i] = wrap ? nxtA[h][i] : curA[h][i];
              PP_LDA(Ay, 1, 1, 0); PP_MMA(0, Ax, Bx); PP_SCHED;
              PP_LDA(Ax, 1, 0, 1); PP_LDB(By, 1, 1); PP_MMA(1, Ay, Bx); PP_SCHED;
              PP_LDA(Ay, 1, 1, 1); PP_MMA(0, Ax, By); PP_SCHED;
              asm volatile("s_waitcnt vmcnt(0) lgkmcnt(0)" ::: "memory"); __builtin_amdgcn_s_barrier();
              PP_STAGE(1, a3o, kb3, b3);
              PP_LDA(Ax, 0, 0, 0); PP_LDB(Bx, 0, 0); PP_MMA(1, Ay, By); PP_SCHED; }
        }
        pr.epi(acc, cur, wr, wc, fr, fq);
        if (!has_next) break;
#pragma unroll
        for (int a = 0; a < 2; ++a)
#pragma unroll
            for (int b = 0; b < 2; ++b)
#pragma unroll
                for (int m = 0; m < 4; ++m)
#pragma unroll
                    for (int n = 0; n < 2; ++n) acc[a][b][m][n] = (f32x4){0.f, 0.f, 0.f, 0.f};
        cur = nxt; cB = nB; ++ui;
#pragma unroll
        for (int h = 0; h < 2; ++h)
#pragma unroll
            for (int i = 0; i < 2; ++i) curA[h][i] = nxtA[h][i];
    }
    asm volatile("s_waitcnt vmcnt(0) lgkmcnt(0)" ::: "memory");
    __builtin_amdgcn_s_barrier();
#undef PP_SA
#undef PP_SB
#undef PP_DMA
#undef PP_STAGE
#undef PP_LDA
#undef PP_LDB
#undef PP_MMA
#undef PP_FILL
#undef PP_SCHED
}

template <class P, int VAR = 0>
__device__ __forceinline__ void gemm_phase_pipe2(LAS unsigned char* lds, const P& pr, const unsigned char* wsbase) {
    static_assert(P::ESZ == 2, "bf16 operands");
    int tid_ = threadIdx.x; asm volatile("" : "+v"(tid_));
    const int tid = tid_, wid = __builtin_amdgcn_readfirstlane(tid >> 6), lane = tid & 63, wr = wid >> 2, wc = wid & 3, fr = lane & 15, fq = lane >> 4;
    const int KB = pr.K() * 2, nk = KB / 64;
    const int srow = lane >> 2, Hs = (0x78 >> (2 * (srow >> 2))) & 3, schunk = (lane & 3) ^ Hs;
    unsigned voffB[2];
#pragma unroll
    for (int i = 0; i < 2; ++i) { const int R = (wid + 8 * i) * 16 + srow; const int Rb = (R & ~31) + perm32(R & 31); voffB[i] = (unsigned)(Rb * KB + schunk * 16); }
    const unsigned ldsw = (unsigned)wid * 1024u;
    const int Hf = (0x78 >> (2 * (fr >> 2))) & 3; const int lofs = (fr * 4 + (fq ^ Hf)) * 16;
    const int aoff = (4 * wr) * 1024 + lofs, boff = 16384 + (2 * wc) * 1024 + lofs;
    const __amdgpu_buffer_rsrc_t rsrc = __builtin_amdgcn_make_buffer_rsrc((void*)wsbase, 0, 0xffffffffu, 0x00020000);
    const unsigned Aoff = (unsigned)((const unsigned char*)pr.A() - wsbase);
#define Q_DMA(ldsoff, voff, soff) do { if constexpr (VAR != 3) __builtin_amdgcn_raw_ptr_buffer_load_lds(rsrc, (LAS unsigned*)(lds + (ldsoff) + ldsw), 16, (voff), (soff), 0, 0); } while (0)
#define Q_STAGE(b, ao, kb, bb) do { _Pragma("unroll") for (int _i = 0; _i < 2; ++_i) { Q_DMA((b) * 32768 + _i * 8192, (ao)[_i], Aoff + (unsigned)(kb)); Q_DMA((b) * 32768 + 16384 + _i * 8192, voffB[_i], (bb) + (unsigned)(kb)); } } while (0)
#define Q_LDA(dst, b, ai) do { if constexpr (VAR != 2) _Pragma("unroll") for (int m = 0; m < 4; ++m) dst[m] = *(const LAS bf16x8*)(lds + (b) * 32768 + aoff + (8 * (ai) + m) * 1024); } while (0)
#define Q_LDB(dst, b) do { if constexpr (VAR != 2) _Pragma("unroll") for (int bj = 0; bj < 2; ++bj) _Pragma("unroll") for (int n = 0; n < 2; ++n) dst[bj][n] = *(const LAS bf16x8*)(lds + (b) * 32768 + boff + (8 * bj + n) * 1024); } while (0)
#define Q_MMA(ai, Af, Bf) do { if constexpr (VAR == 1) { _Pragma("unroll") for (int m = 0; m < 4; ++m) asm volatile("" :: "v"(Af[m])); _Pragma("unroll") for (int bj = 0; bj < 2; ++bj) _Pragma("unroll") for (int n = 0; n < 2; ++n) asm volatile("" :: "v"(Bf[bj][n])); } \
        else _Pragma("unroll") for (int m = 0; m < 4; ++m) _Pragma("unroll") for (int bj = 0; bj < 2; ++bj) _Pragma("unroll") for (int n = 0; n < 2; ++n) \
        acc[ai][bj][m][n] = __builtin_amdgcn_mfma_f32_16x16x32_bf16(Bf[bj][n], Af[m], acc[ai][bj][m][n], 0, 0, 0); } while (0)
#define Q_FILL(u, o) do { _Pragma("unroll") for (int _i = 0; _i < 2; ++_i) (o)[_i] = (unsigned)(pr.arow((u), (wid + 8 * _i) * 16 + srow) * 2 + (size_t)schunk * 16); } while (0)
#define Q_SCHED __builtin_amdgcn_sched_barrier(0)
#define Q_STEP(b, ks, Bc, Bn) do { const int _g = (ks) + 4; const bool _w = _g >= nk; const unsigned _kb = (unsigned)(_w ? _g - nk : _g) * 64u; const unsigned _bb = _w ? nB : cB; \
        unsigned _ao[2]; _ao[0] = _w ? nxtA[0] : curA[0]; _ao[1] = _w ? nxtA[1] : curA[1]; \
        Q_LDA(Ay, b, 1); Q_MMA(0, Ax, Bc); Q_SCHED; \
        asm volatile("s_waitcnt vmcnt(8) lgkmcnt(0)" ::: "memory"); __builtin_amdgcn_s_barrier();      \
        Q_STAGE(b, _ao, _kb, _bb); \
        Q_LDA(Ax, ((b) + 1) & 3, 0); Q_LDB(Bn, ((b) + 1) & 3); Q_MMA(1, Ay, Bc); Q_SCHED; } while (0)
    Unit cur, nxt; int ui = 0;
    if (!pr.next(0, cur)) return;
    Acc acc;
#pragma unroll
    for (int a = 0; a < 2; ++a)
#pragma unroll
        for (int b = 0; b < 2; ++b)
#pragma unroll
            for (int m = 0; m < 4; ++m)
#pragma unroll
                for (int n = 0; n < 2; ++n) acc[a][b][m][n] = (f32x4){0.f, 0.f, 0.f, 0.f};
    bf16x8 Ax[4] = {}, Ay[4] = {}, Bx[2][2] = {}, By[2][2] = {};
    unsigned curA[2], nxtA[2];
    Q_FILL(cur, curA);
    unsigned cB = (unsigned)((const unsigned char*)pr.B(cur) - wsbase), nB = cB;
    Q_STAGE(0, curA, 0, cB); Q_STAGE(1, curA, 64, cB); Q_STAGE(2, curA, 128, cB); Q_STAGE(3, curA, 192, cB);
    asm volatile("s_waitcnt vmcnt(12)" ::: "memory"); __builtin_amdgcn_s_barrier();
    Q_LDA(Ax, 0, 0); Q_LDB(Bx, 0);
    for (;;) {
        const bool has_next = pr.next(ui + 1, nxt);
        nB = cB;
        if (has_next) { Q_FILL(nxt, nxtA); nB = (unsigned)((const unsigned char*)pr.B(nxt) - wsbase); } else { nxtA[0] = curA[0]; nxtA[1] = curA[1]; }
#pragma unroll 1
        for (int ks = 0; ks < nk; ks += 4) { Q_STEP(0, ks, Bx, By); Q_STEP(1, ks + 1, By, Bx); Q_STEP(2, ks + 2, Bx, By); Q_STEP(3, ks + 3, By, Bx); }
        pr.epi(acc, cur, wr, wc, fr, fq);
        if (!has_next) break;
#pragma unroll
        for (int a = 0; a < 2; ++a)
#pragma unroll
            for (int b = 0; b < 2; ++b)
#pragma unroll
                for (int m = 0; m < 4; ++m)
#pragma unroll
                    for (int n = 0; n < 2; ++n) acc[a][b][m][n] = (f32x4){0.f, 0.f, 0.f, 0.f};
        cur = nxt; cB = nB; curA[0] = nxtA[0]; curA[1] = nxtA[1]; ++ui;
    }
    asm volatile("s_waitcnt vmcnt(0) lgkmcnt(0)" ::: "memory");
    __builtin_amdgcn_s_barrier();
#undef Q_DMA
#undef Q_STAGE
#undef Q_LDA
#undef Q_LDB
#undef Q_MMA
#undef Q_FILL
#undef Q_SCHED
#undef Q_STEP
}
}

template <class P> __device__ __forceinline__ void ref_gemm_phase(const P& pr) {
    const int tid = threadIdx.x, wid = tid >> 6, lane = tid & 63;
    Unit u;
    Acc acc; bool keep = false;
    for (int i = 0; pr.next(i, u); ++i) { ref_gemm_thread(pr, u, tid, acc, keep); bool mid = false;
        if constexpr (P::HAS_MID) { mid = pr.is_mid(u); if (mid) pr.epi_mid(acc, u, wid >> 2, wid & 3, lane & 15, lane >> 4); else pr.epi(acc, u, wid >> 2, wid & 3, lane & 15, lane >> 4); } else pr.epi(acc, u, wid >> 2, wid & 3, lane & 15, lane >> 4);
        keep = mid; }
}
template <class P> __device__ __forceinline__ void run_gemm(LAS unsigned char* lds, const P& pr, const unsigned char* wsbase) {
#if USE_MFMA_GEMM
    if constexpr (P::ESZ == 2 && GEMM_PIPE == 2 && !P::HAS_MID) pg8::gemm_phase_pipe2<P>(lds, pr, wsbase); else if constexpr (P::ESZ == 2 && GEMM_PIPE == 1 && !P::HAS_MID) pg8::gemm_phase_pipe<P>(lds, pr, wsbase); else pg8::gemm_phase<P>(lds, pr, wsbase);
#endif
}
template <int WHICH> __global__ void __launch_bounds__(NTHREADS) ref_gemm_kernel(Params p) {
    const GridPos gp{(int)gridDim.x, (int)blockIdx.x};
    if constexpr (WHICH == 1) { const ProbInProj pr = mk_inproj(p, gp); ref_gemm_phase(pr); }
    if constexpr (WHICH == 2) { const ProbUpQ pr = mk_upq(p, gp); ref_gemm_phase(pr); }
    if constexpr (WHICH == 3) { const ProbUpKV pr = mk_upkv(p, gp); ref_gemm_phase(pr); }
    if constexpr (WHICH == 7) { const ProbBranch pr = mk_branch(p, gp); ref_gemm_phase(pr); }
    if constexpr (WHICH == 8) { const ProbOut pr = mk_out(p, gp); ref_gemm_phase(pr); }
    if constexpr (WHICH == 12) { const ProbMoe1 pr = mk_moe1(p, gp, 0); ref_gemm_phase(pr); }
    if constexpr (WHICH == 13) { const ProbMoe2 pr = mk_moe2(p, gp, 0); ref_gemm_phase(pr); }
    if constexpr (WHICH == 15) { const ProbMoe1 pr = mk_moe1(p, gp, 1); ref_gemm_phase(pr); }
    if constexpr (WHICH == 16) { const ProbMoe2 pr = mk_moe2(p, gp, 1); ref_gemm_phase(pr); }
}
template <int WHICH> __global__ void __launch_bounds__(256) ref_attn_kernel(Params p) {
    const long gthreads = (long)gridDim.x * 256, gtid = (long)blockIdx.x * 256 + threadIdx.x;
    const long per = gthreads / SEQ > 0 ? gthreads / SEQ : 1;
    for (long it = gtid; it < (long)NTOK * 8; it += gthreads) { const long bh = it / SEQ; const int pos = (int)(it % SEQ); const bool flip = ((bh / per) & 1) != 0; const long item = bh * SEQ + (flip ? SEQ - 1 - pos : pos);
        if constexpr (WHICH == 4) ref_attn_mla_item(p, item); else ref_attn_diff_item(p, item); }
}

namespace att {
typedef short bf16x8 __attribute__((ext_vector_type(8)));
typedef short s16x4 __attribute__((ext_vector_type(4)));
typedef float f32x16 __attribute__((ext_vector_type(16)));
#define ATT_SBAR() __builtin_amdgcn_sched_barrier(0)
__device__ __forceinline__ int crow(int r, int hi) { return (r & 3) + 8 * (r >> 2) + 4 * hi; }
__device__ __forceinline__ unsigned cvtpk(float lo, float hi) { unsigned r; asm volatile("v_cvt_pk_bf16_f32 %0, %1, %2" : "=v"(r) : "v"(lo), "v"(hi)); return r; }

__device__ __forceinline__ float max3f(float a, float b, float c) { float r; asm("v_max3_f32 %0, %1, %2, %3" : "=v"(r) : "v"(a), "v"(b), "v"(c)); return r; }
constexpr float THR2 = 8.f * 1.4426950408889634f;
__device__ __forceinline__ void rowmax_lo(const f32x16& p0, const f32x16& p1, float& a, float& b) {
    a = max3f(p0[0], p0[1], p1[0]); b = max3f(p0[2], p0[3], p1[1]); a = max3f(a, p1[2], p1[3]);
    a = max3f(a, p0[4], p0[5]); b = max3f(b, p0[6], p0[7]); a = max3f(a, p1[4], p1[5]); b = max3f(b, p1[6], p1[7]);
}
__device__ __forceinline__ float rowmax_hi(const f32x16& p0, const f32x16& p1, float a, float b) {
#pragma unroll
    for (int r = 8; r < 16; r += 4) { a = max3f(a, p0[r], p0[r + 1]); b = max3f(b, p0[r + 2], p0[r + 3]); a = max3f(a, p1[r], p1[r + 1]); b = max3f(b, p1[r + 2], p1[r + 3]); }
    float pmax = fmaxf(a, b);
    auto rr = __builtin_amdgcn_permlane32_swap(__float_as_uint(pmax), __float_as_uint(pmax), false, false);
    return fmaxf(__uint_as_float(rr[0]), __uint_as_float(rr[1]));
}
template <bool FORCE, bool NOEXP = false> __device__ __forceinline__ void partialSM_rest(f32x16& p0, f32x16& p1, float pmax, float& m_reg, float& alpha, f32x16& negm) {
    if (!FORCE && __builtin_expect(__all(pmax <= THR2), 1)) { alpha = 1.f; }
    else {
        const float d = FORCE ? pmax : fmaxf(pmax, 0.f);
        m_reg += d; alpha = FORCE ? 1.f : __builtin_amdgcn_exp2f(-d);
#pragma unroll
        for (int r = 0; r < 16; ++r) { p0[r] -= d; p1[r] -= d; negm[r] = -m_reg; }
    }
    if constexpr (!NOEXP) {
#pragma unroll
    for (int r = 0; r < 16; ++r) p0[r] = __builtin_amdgcn_exp2f(p0[r]); }
}
template <bool FORCE> __device__ __forceinline__ void partialSM(f32x16& p0, f32x16& p1, float& m_reg, float& alpha, f32x16& negm) {
    float a, b; rowmax_lo(p0, p1, a, b); const float pmax = rowmax_hi(p0, p1, a, b); partialSM_rest<FORCE>(p0, p1, pmax, m_reg, alpha, negm);
}
template <bool ONES, bool NOEXP = false> __device__ __forceinline__ void finishSM(f32x16& p0, f32x16& p1, float alpha, float& l_reg, bf16x8& pa0, bf16x8& pa1, bf16x8& pa2, bf16x8& pa3) {
    if constexpr (!NOEXP) {
#pragma unroll
    for (int r = 0; r < 16; ++r) p1[r] = __builtin_amdgcn_exp2f(p1[r]); }
    if constexpr (!ONES) { float ps = 0;
#pragma unroll
        for (int r = 0; r < 16; ++r) ps += p0[r];
#pragma unroll
        for (int r = 0; r < 16; ++r) ps += p1[r];
        auto rr = __builtin_amdgcn_permlane32_swap(__float_as_uint(ps), __float_as_uint(ps), false, false);
        ps = __uint_as_float(rr[0]) + __uint_as_float(rr[1]);
        l_reg = l_reg * alpha + ps; }
#define ATT_PK4(P, BASE, OUT) do { unsigned a0 = cvtpk(P[BASE + 0], P[BASE + 1]), a1 = cvtpk(P[BASE + 2], P[BASE + 3]);   \
    unsigned b0 = cvtpk(P[BASE + 4], P[BASE + 5]), b1 = cvtpk(P[BASE + 6], P[BASE + 7]);                              \
    auto r0 = __builtin_amdgcn_permlane32_swap(a0, b0, false, false); auto r1 = __builtin_amdgcn_permlane32_swap(a1, b1, false, false); \
    u32x4 w = {r0[0], r1[0], r0[1], r1[1]}; OUT = __builtin_bit_cast(bf16x8, w); } while (0)
    ATT_PK4(p0, 0, pa0); ATT_PK4(p0, 8, pa1); ATT_PK4(p1, 0, pa2); ATT_PK4(p1, 8, pa3);
#undef ATT_PK4
}
__device__ __forceinline__ void cmask(f32x16& p0, f32x16& p1, int jb, int qrel, int hi) {
    const int kb = 64 * jb + 4 * hi;
#pragma unroll
    for (int r = 0; r < 16; ++r) { const int kv = kb + (r & 3) + 8 * (r >> 2); if (kv > qrel) p0[r] = -INFINITY; if (kv + 32 > qrel) p1[r] = -INFINITY; }
}
template <int OFF> __device__ __forceinline__ s16x4 tr_read(int vb) {
    s16x4 r; asm volatile("ds_read_b64_tr_b16 %0, %1 offset:%2" : "=&v"(r) : "v"(vb), "i"(OFF) : "memory"); return r;
}
#define ATT_PV_BLOCK(NCBv, D0v, od, FILL) do { constexpr int KS = (NCBv) * 1024, HF = (NCBv) * 512, B = (D0v) * 512; \
    const s16x4 l0 = tr_read<B + 0 * KS>(vb), h0 = tr_read<B + 0 * KS + HF>(vb), l1 = tr_read<B + 1 * KS>(vb), h1 = tr_read<B + 1 * KS + HF>(vb); \
    const s16x4 l2 = tr_read<B + 2 * KS>(vb), h2 = tr_read<B + 2 * KS + HF>(vb), l3 = tr_read<B + 3 * KS>(vb), h3 = tr_read<B + 3 * KS + HF>(vb); \
    FILL; \
    asm volatile("s_waitcnt lgkmcnt(0)" ::: "memory"); ATT_SBAR(); \
    od = __builtin_amdgcn_mfma_f32_32x32x16_bf16(pa0, ATT_PK(l0, h0), od, 0, 0, 0); od = __builtin_amdgcn_mfma_f32_32x32x16_bf16(pa1, ATT_PK(l1, h1), od, 0, 0, 0); \
    od = __builtin_amdgcn_mfma_f32_32x32x16_bf16(pa2, ATT_PK(l2, h2), od, 0, 0, 0); od = __builtin_amdgcn_mfma_f32_32x32x16_bf16(pa3, ATT_PK(l3, h3), od, 0, 0, 0); } while (0)
#define ATT_PK(L, H) (bf16x8){L[0], L[1], L[2], L[3], H[0], H[1], H[2], H[3]}
template <int NCBV, int NB> __device__ __forceinline__ void pv_all(f32x16* o, int vb, bf16x8 pa0, bf16x8 pa1, bf16x8 pa2, bf16x8 pa3) {
    ATT_PV_BLOCK(NCBV, 0, o[0], (void)0); ATT_PV_BLOCK(NCBV, 1, o[1], (void)0);
    if constexpr (NB >= 3) ATT_PV_BLOCK(NCBV, 2, o[2], (void)0);
    if constexpr (NB >= 4) ATT_PV_BLOCK(NCBV, 3, o[3], (void)0);
    if constexpr (NB >= 5) ATT_PV_BLOCK(NCBV, 4, o[4], (void)0);
}
template <int NCBV, int NB> __device__ __forceinline__ float pv_all_max(f32x16* o, int vb, bf16x8 pa0, bf16x8 pa1, bf16x8 pa2, bf16x8 pa3, const f32x16& q0, const f32x16& q1) {
    float a, b, pmax;
    ATT_PV_BLOCK(NCBV, 0, o[0], rowmax_lo(q0, q1, a, b)); ATT_PV_BLOCK(NCBV, 1, o[1], pmax = rowmax_hi(q0, q1, a, b));
    if constexpr (NB >= 3) ATT_PV_BLOCK(NCBV, 2, o[2], (void)0);
    if constexpr (NB >= 4) ATT_PV_BLOCK(NCBV, 3, o[3], (void)0);
    if constexpr (NB >= 5) ATT_PV_BLOCK(NCBV, 4, o[4], (void)0);
    return pmax;
}
template <int DQK, int DV> struct Cfg {
    static constexpr bool ONES = false;
    static constexpr int KSTR = DQK * 2 + 16, SHM_K = 64 * KSTR, NCB = DV / 32, NCBV = NCB + (ONES ? 1 : 0), NB = NCBV, SHM_V = 64 * NCBV * 32 * 2;
    static constexpr int CK = DQK / 8, NKC = 64 * CK, NKL = (NKC + 511) / 512, CV = DV / 8, NVL = 64 * CV / 512;
    static constexpr int OFF_V = 0, OFF_K = 2 * SHM_V, OFF_WS = OFF_K + 2 * SHM_K, OFF_O = OFF_WS + NWAVES * 64 * 4, LDS_NEED = OFF_O + NWAVES * 32 * DV * 2;
    static_assert(LDS_NEED <= RING_BYTES && (OFF_WS % 16) == 0, "attention LDS map");
};
template <int NCB> __device__ __forceinline__ int v_st(int k, int c) { const int kk = (k & ~0xC) | ((k & 4) << 1) | ((k & 8) >> 1); return ((kk >> 3) * NCB + (c >> 5)) * 512 + ((kk & 7) * 32 + (c & 31)) * 2; }
__device__ __forceinline__ int v_rd_base(int lane) { return ((lane & 3) << 3) | (((lane >> 2) & 3) << 6) | (((lane >> 4) & 1) << 5) | (((lane >> 5) & 1) << 8); }

template <int DQK, int DV, int AVAR = 0, int MODE = 0, bool SMAX = false>
__device__ __forceinline__ void attn_unit(LAS unsigned char* lds, const bf16_t* __restrict__ Qb, int ldq, const bf16_t* __restrict__ Kh, int ldk, const bf16_t* __restrict__ Vh, int ldv,
                                          bf16_t* __restrict__ Ob, int ldo, int q0, float lam = 0.f, const float* __restrict__ subln = nullptr, float Mb = 0.f,
                                          const float* __restrict__ qgain = nullptr, const float* __restrict__ qtab = nullptr, const float* __restrict__ rqp = nullptr) {
    typedef Cfg<DQK, DV> C_; constexpr bool ONES = C_::ONES; constexpr int NCB = C_::NCB, NCBV = C_::NCBV, KSTR = C_::KSTR, SHM_K = C_::SHM_K, SHM_V = C_::SHM_V, CK = C_::CK, CV = C_::CV, NKL = C_::NKL, NVL = C_::NVL, ND = DQK / 16;
    int tid_ = threadIdx.x; asm volatile("" : "+v"(tid_));
    const int tid = tid_, wid = __builtin_amdgcn_readfirstlane(tid >> 6), lane = tid & 63, r32 = lane & 31, hi = lane >> 5;
    LAS unsigned char* V_lds = lds + C_::OFF_V; LAS unsigned char* K_lds = lds + C_::OFF_K;
    LAS float* ws = (LAS float*)(lds + C_::OFF_WS) + wid * 64; LAS float* al_l = ws + 32;
    LAS unsigned char* Ost = lds + C_::OFF_O + wid * (32 * DV * 2);
    float m_reg = 0.f, l_reg = 0.f; f32x16 o[NCBV]; f32x16 negm = f32x16{};
    if constexpr (SMAX) {
#pragma unroll
        for (int r = 0; r < 16; ++r) negm[r] = -Mb; }
#pragma unroll
    for (int d = 0; d < NCBV; ++d) o[d] = f32x16{};
    bf16x8 qr[ND];
    { const bf16_t* Qw = Qb + (size_t)(wid * 32 + r32) * ldq + hi * 8;
#pragma unroll
      for (int d0 = 0; d0 < ND; ++d0) qr[d0] = *(const bf16x8*)(Qw + d0 * 16); }
    { constexpr int NF = (DQK == 96) ? 16 : 32; constexpr float QS = (DQK == 96) ? QSCALE_MLA : QSCALE_DIFF;
      float x[ND][8]; float ss = 0.f;
#pragma unroll
      for (int d0 = 0; d0 < ND; ++d0) { const u32x4 w = __builtin_bit_cast(u32x4, qr[d0]); unpack8(w, x[d0]);
#pragma unroll
          for (int j = 0; j < 8; ++j) ss += x[d0][j] * x[d0][j]; }
      { auto rr = __builtin_amdgcn_permlane32_swap(__float_as_uint(ss), __float_as_uint(ss), false, false); ss = __uint_as_float(rr[0]) + __uint_as_float(rr[1]); }
      const float rq = rqp ? rqp[wid * 32 + r32] : 1.0f;
      const float rs = QS * rq / sqrtf(ss * rq * rq * (1.0f / DQK) + EPS);
#pragma unroll
      for (int d0 = 0; d0 < ND; ++d0)
#pragma unroll
          for (int j = 0; j < 8; ++j) x[d0][j] *= rs * qgain[d0 * 16 + 8 * hi + j];
      const float* tb = qtab + (size_t)(wid * 32 + r32) * (2 * NF);
      constexpr int DB = NF / 16;
#pragma unroll
      for (int d0 = ND - 2 * DB; d0 < ND - DB; ++d0)
#pragma unroll
          for (int j = 0; j < 8; ++j) { const int fi = (d0 - (ND - 2 * DB)) * 16 + 8 * hi + j; const float cs = tb[2 * fi], sn = tb[2 * fi + 1]; const float x1 = x[d0][j], x2 = x[d0 + DB][j];
              x[d0][j] = x1 * cs - x2 * sn; x[d0 + DB][j] = x2 * cs + x1 * sn; }
#pragma unroll
      for (int d0 = 0; d0 < ND; ++d0) qr[d0] = __builtin_bit_cast(bf16x8, pack8(x[d0])); }
    int krow[NKL], kcc[NKL], vrow[NVL], vcc[NVL];
#pragma unroll
    for (int i = 0; i < NKL; ++i) { const int id = (tid + 512 * i) % C_::NKC; krow[i] = id / CK; kcc[i] = id % CK; }
#pragma unroll
    for (int i = 0; i < NVL; ++i) { const int id = tid + 512 * i; vrow[i] = id / CV; vcc[i] = id % CV; }
    const int vb0 = (int)(uintptr_t)(V_lds) + v_rd_base(lane);
    bf16x8 sk[2][NKL], sv[2][NVL];
#define ATT_SLOAD(s, k0) do { _Pragma("unroll") for (int _i = 0; _i < NKL; ++_i) sk[s][_i] = *(const bf16x8*)(Kh + (size_t)((k0) + krow[_i]) * ldk + kcc[_i] * 8); \
        _Pragma("unroll") for (int _i = 0; _i < NVL; ++_i) sv[s][_i] = *(const bf16x8*)(Vh + (size_t)((k0) + vrow[_i]) * ldv + vcc[_i] * 8); } while (0)
#define ATT_SWRITE(b, s) do { _Pragma("unroll") for (int _i = 0; _i < NKL; ++_i) *(LAS bf16x8*)(K_lds + (b) * SHM_K + krow[_i] * KSTR + kcc[_i] * 16) = sk[s][_i]; \
        _Pragma("unroll") for (int _i = 0; _i < NVL; ++_i) *(LAS bf16x8*)(V_lds + (b) * SHM_V + v_st<NCBV>(vrow[_i], vcc[_i] * 8)) = sv[s][_i]; } while (0)
#define ATT_QKT(P0, P1, b) do { const LAS unsigned char* _kb = K_lds + (b) * SHM_K + r32 * KSTR + hi * 16; \
        { const bf16x8 _b0 = *(const LAS bf16x8*)(_kb), _b1 = *(const LAS bf16x8*)(_kb + 32 * KSTR); \
          P0 = __builtin_amdgcn_mfma_f32_32x32x16_bf16(_b0, qr[0], negm, 0, 0, 0); P1 = __builtin_amdgcn_mfma_f32_32x32x16_bf16(_b1, qr[0], negm, 0, 0, 0); } \
        _Pragma("unroll") for (int _d = 1; _d < ND; ++_d) { const bf16x8 _b0 = *(const LAS bf16x8*)(_kb + _d * 32), _b1 = *(const LAS bf16x8*)(_kb + 32 * KSTR + _d * 32); \
            P0 = __builtin_amdgcn_mfma_f32_32x32x16_bf16(_b0, qr[_d], P0, 0, 0, 0); P1 = __builtin_amdgcn_mfma_f32_32x32x16_bf16(_b1, qr[_d], P1, 0, 0, 0); } } while (0)
#define ATT_MASK(P0, P1, j) do { if ((j) >= NT - 4) cmask(P0, P1, (j) - (NT - 4), 32 * wid + r32, hi); } while (0)
#define ATT_RESC(a) do { if (__any((a) < 1.f)) { if (hi == 0) al_l[r32] = (a); asm volatile("s_waitcnt lgkmcnt(0)" ::: "memory"); \
        _Pragma("unroll") for (int _d = 0; _d < NCBV; ++_d) _Pragma("unroll") for (int _r = 0; _r < 16; ++_r) o[_d][_r] *= al_l[crow(_r, hi)]; } } while (0)
#define ATT_SYNC() do { if constexpr (AVAR != 1) __syncthreads(); } while (0)
    f32x16 pA0, pA1, pB0, pB1; float alA, alB; bf16x8 pa0, pa1, pa2, pa3;
    const int NT = (q0 + 256) / 64;
    __syncthreads();
    if constexpr (ONES) { const int bsel = tid >> 8, idx = tid & 255;
      *(LAS u32x4*)(V_lds + bsel * SHM_V + ((idx >> 5) * NCBV + NCB) * 512 + (idx & 31) * 16) = (u32x4){0x3f803f80u, 0x3f803f80u, 0x3f803f80u, 0x3f803f80u}; }
    ATT_SLOAD(0, 0); asm volatile("s_waitcnt vmcnt(0)" ::: "memory"); ATT_SWRITE(0, 0); __syncthreads();
    if constexpr (SMAX) {
#define ATT_EXP_LO(P0) do { _Pragma("unroll") for (int _r = 0; _r < 16; ++_r) P0[_r] = __builtin_amdgcn_exp2f(P0[_r]); } while (0)
        ATT_QKT(pA0, pA1, 0); ATT_MASK(pA0, pA1, 0); ATT_EXP_LO(pA0);
        ATT_SLOAD(1, 64); ATT_SLOAD(0, 128);
        ATT_SWRITE(1, 1); __syncthreads();
        for (int j = 1; j + 1 < NT; j += 2) {
            ATT_SBAR(); ATT_QKT(pB0, pB1, 1); ATT_MASK(pB0, pB1, j);
            finishSM<ONES>(pA0, pA1, 1.f, l_reg, pa0, pa1, pa2, pa3); ATT_SBAR();
            ATT_SLOAD(1, (j + 2) * 64); ATT_SBAR();
            pv_all<NCBV, NCBV>(o, vb0, pa0, pa1, pa2, pa3); ATT_EXP_LO(pB0);
            __syncthreads(); ATT_SWRITE(0, 0); __syncthreads();
            ATT_SBAR(); ATT_QKT(pA0, pA1, 0); ATT_MASK(pA0, pA1, j + 1);
            finishSM<ONES>(pB0, pB1, 1.f, l_reg, pa0, pa1, pa2, pa3); ATT_SBAR();
            ATT_SLOAD(0, (j + 3 < NT ? j + 3 : NT - 1) * 64);
            ATT_SBAR();
            pv_all<NCBV, NCBV>(o, vb0 + SHM_V, pa0, pa1, pa2, pa3); ATT_EXP_LO(pA0);
            __syncthreads(); ATT_SWRITE(1, 1); __syncthreads();
        }
        ATT_SBAR(); ATT_QKT(pB0, pB1, 1); ATT_MASK(pB0, pB1, NT - 1);
        finishSM<ONES>(pA0, pA1, 1.f, l_reg, pa0, pa1, pa2, pa3); ATT_SBAR();
        pv_all<NCBV, NCBV>(o, vb0, pa0, pa1, pa2, pa3); ATT_EXP_LO(pB0);
        __syncthreads();
        finishSM<ONES>(pB0, pB1, 1.f, l_reg, pa0, pa1, pa2, pa3); ATT_SBAR();
        pv_all<NCBV, NCBV>(o, vb0 + SHM_V, pa0, pa1, pa2, pa3);
#undef ATT_EXP_LO
    } else {
    ATT_QKT(pA0, pA1, 0); ATT_MASK(pA0, pA1, 0); partialSM<true>(pA0, pA1, m_reg, alA, negm);
    ATT_SLOAD(1, 64); ATT_SLOAD(0, 128);
    ATT_SWRITE(1, 1); __syncthreads();
    for (int j = 1; j + 1 < (AVAR == 6 ? 0 : NT); j += 2) {
        ATT_SBAR(); if constexpr (AVAR != 3) ATT_QKT(pB0, pB1, 1); else { pB0 = negm; pB1 = negm; } ATT_MASK(pB0, pB1, j);
        finishSM<ONES, AVAR == 2>(pA0, pA1, alA, l_reg, pa0, pa1, pa2, pa3); ATT_SBAR();
        if constexpr (AVAR != 5) ATT_SLOAD(1, (j + 2) * 64); ATT_SBAR();
        { float pm; if constexpr (AVAR != 4) pm = pv_all_max<NCBV, NCBV>(o, vb0, pa0, pa1, pa2, pa3, pB0, pB1); else { float a_, b_; rowmax_lo(pB0, pB1, a_, b_); pm = rowmax_hi(pB0, pB1, a_, b_); asm volatile("" :: "v"(pa0), "v"(pa1), "v"(pa2), "v"(pa3)); } partialSM_rest<false, AVAR == 2>(pB0, pB1, pm, m_reg, alB, negm); }
        ATT_SYNC(); if constexpr (AVAR != 5) ATT_SWRITE(0, 0);
        ATT_RESC(alB); ATT_SYNC();
        ATT_SBAR(); if constexpr (AVAR != 3) ATT_QKT(pA0, pA1, 0); else { pA0 = negm; pA1 = negm; } ATT_MASK(pA0, pA1, j + 1);
        finishSM<ONES, AVAR == 2>(pB0, pB1, alB, l_reg, pa0, pa1, pa2, pa3); ATT_SBAR();
        if constexpr (AVAR != 5) ATT_SLOAD(0, (j + 3 < NT ? j + 3 : NT - 1) * 64);
        ATT_SBAR();
        { float pm; if constexpr (AVAR != 4) pm = pv_all_max<NCBV, NCBV>(o, vb0 + SHM_V, pa0, pa1, pa2, pa3, pA0, pA1); else { float a_, b_; rowmax_lo(pA0, pA1, a_, b_); pm = rowmax_hi(pA0, pA1, a_, b_); asm volatile("" :: "v"(pa0), "v"(pa1), "v"(pa2), "v"(pa3)); } partialSM_rest<false, AVAR == 2>(pA0, pA1, pm, m_reg, alA, negm); }
        ATT_SYNC(); if constexpr (AVAR != 5) ATT_SWRITE(1, 1);
        ATT_RESC(alA); ATT_SYNC();
    }
    ATT_SBAR(); ATT_QKT(pB0, pB1, 1); ATT_MASK(pB0, pB1, NT - 1);
    finishSM<ONES>(pA0, pA1, alA, l_reg, pa0, pa1, pa2, pa3); ATT_SBAR();
    { const float pm = pv_all_max<NCBV, NCBV>(o, vb0, pa0, pa1, pa2, pa3, pB0, pB1); partialSM_rest<false>(pB0, pB1, pm, m_reg, alB, negm); }
    __syncthreads(); ATT_RESC(alB);
    finishSM<ONES>(pB0, pB1, alB, l_reg, pa0, pa1, pa2, pa3); ATT_SBAR();
    pv_all<NCBV, NCBV>(o, vb0 + SHM_V, pa0, pa1, pa2, pa3);
    }
    if constexpr (!ONES) { if (hi == 0) al_l[r32] = l_reg; asm volatile("s_waitcnt lgkmcnt(0)" ::: "memory"); }
    if constexpr (MODE == 2) {
#pragma unroll
        for (int r = 0; r < 16; ++r) { const int orow = crow(r, hi); float lsum; if constexpr (ONES) lsum = o[NCB][r]; else lsum = al_l[orow]; const float rl = __builtin_amdgcn_rcpf(lsum); float ss = 0.f;
#pragma unroll
            for (int d0 = 0; d0 < NCB; ++d0) { const float o1 = bf2f(*(const LAS bf16_t*)(Ost + (orow * DV + d0 * 32 + r32) * 2)); const float x = o1 - lam * bf2f(f2bf(o[d0][r] * rl)); o[d0][r] = x; ss += x * x; }
            ss += __shfl_xor(ss, 1); ss += __shfl_xor(ss, 2); ss += __shfl_xor(ss, 4); ss += __shfl_xor(ss, 8); ss += __shfl_xor(ss, 16);
            const float rs = (1.0f - LAMBDA_INIT) / sqrtf(ss * (1.0f / DV) + EPS);
#pragma unroll
            for (int d0 = 0; d0 < NCB; ++d0) *(LAS bf16_t*)(Ost + (orow * DV + d0 * 32 + r32) * 2) = f2bf(o[d0][r] * rs * subln[d0 * 32 + r32]); }
    } else {
#pragma unroll
        for (int r = 0; r < 16; ++r) { const int orow = crow(r, hi); float lsum; if constexpr (ONES) lsum = o[NCB][r]; else lsum = al_l[orow]; const float rl = __builtin_amdgcn_rcpf(lsum);
#pragma unroll
            for (int d0 = 0; d0 < NCB; ++d0) *(LAS bf16_t*)(Ost + (orow * DV + d0 * 32 + r32) * 2) = f2bf(o[d0][r] * rl); }
    }
    asm volatile("s_waitcnt lgkmcnt(0)" ::: "memory");
    if constexpr (MODE != 1) {
#pragma unroll
    for (int i = 0; i < CV / 2; ++i) { const int id = lane + 64 * i, row = id / CV, cc = id % CV;
        const u32x4 w = *(const LAS u32x4*)(Ost + (row * DV + cc * 8) * 2);
        *(u32x4*)(Ob + (size_t)(wid * 32 + row) * ldo + cc * 8) = w; }
    }
#undef ATT_SYNC
#undef ATT_SLOAD
#undef ATT_SWRITE
#undef ATT_QKT
#undef ATT_MASK
#undef ATT_RESC
}
__device__ __forceinline__ bool attn_next(const GridPos& g, int i, int& bh, int& qb) {
    constexpr int NBH = BATCH * 8, NQB = SEQ / 256;
    if (g.G % 8 == 0 && g.G / 8 == NQB && NBH % 8 == 0) { if (i >= NBH / 8) return false; const int xcd = g.c % 8, r = g.c / 8; bh = xcd * (NBH / 8) + i; qb = ((i >> 1) & 1) ? NQB - 1 - r : r; return true; }
    const long u = (long)(i >> 1) * g.G + g.c; if (u >= (long)NBH / 2 * NQB) return false; bh = (int)(u / NQB) * 2 + (i & 1); qb = (int)(u % NQB); return true;
}
}
constexpr float SBOUND_MAX = 40.f;
__device__ __forceinline__ void attn_mla_phase(LAS unsigned char* lds, const Params& p, const GridPos& g) {
    int bh, qb; const float Mb = wsp<float>(p, WS_MISC + MS_SBOUND)[0];
#define MLA_UNIT(SM) { const int b = bh >> 3, h = bh & 7; const size_t tok0 = (size_t)b * SEQ, row0 = tok0 + (size_t)qb * 256; \
        att::attn_unit<96, 64, 0, 0, SM>(lds, wsp<bf16_t>(p, WS_QA) + row0 * QA_W + h * 96, QA_W, wsp<bf16_t>(p, WS_KV) + tok0 * KV_W + h * 160, KV_W, wsp<bf16_t>(p, WS_KV) + tok0 * KV_W + h * 160 + 96, KV_W, \
                               wsp<bf16_t>(p, WS_OA) + row0 * 512 + h * 64, 512, qb * 256, 0.f, nullptr, Mb, p.mla_q_norm, wsp<float>(p, WS_ROPE) + (size_t)(qb * 256) * 32, wsp<float>(p, WS_MISC + MS_RQ) + row0); }
    if (Mb < SBOUND_MAX) { for (int i = 0; att::attn_next(g, i, bh, qb); ++i) MLA_UNIT(true) }
    else { for (int i = 0; att::attn_next(g, i, bh, qb); ++i) MLA_UNIT(false) }
#undef MLA_UNIT
}
__device__ __forceinline__ void attn_diff_phase(LAS unsigned char* lds, const Params& p, const GridPos& g) {
    int bh, qb; const bf16_t* proj = wsp<bf16_t>(p, WS_PROJ); const float lam = *wsp<float>(p, WS_MISC + MS_LAMBDA); const float Mb = wsp<float>(p, WS_MISC + MS_SBOUND)[1];
#define DIFF_PAIR(SM) { const int b = bh >> 3, h = bh & 7; const size_t tok0 = (size_t)b * SEQ, row0 = tok0 + (size_t)qb * 256; \
        const bf16_t* vp = proj + tok0 * PROJ_W + PC_DV + (h >> 1) * 128; bf16_t* ob = wsp<bf16_t>(p, WS_OB) + row0 * 512 + (h >> 1) * 128; \
        att::attn_unit<64, 128, 0, 1, SM>(lds, proj + row0 * PROJ_W + PC_DQ + h * 64, PROJ_W, proj + tok0 * PROJ_W + PC_DK + h * 64, PROJ_W, vp, PROJ_W, ob, 512, qb * 256, 0.f, nullptr, Mb, p.diff_q_norm, wsp<float>(p, WS_ROPE) + (size_t)SEQ * 32 + (size_t)(qb * 256) * 64, nullptr); \
        att::attn_unit<64, 128, 0, 2, SM>(lds, proj + row0 * PROJ_W + PC_DQ + (h + 1) * 64, PROJ_W, proj + tok0 * PROJ_W + PC_DK + (h + 1) * 64, PROJ_W, vp, PROJ_W, ob, 512, qb * 256, lam, p.subln, Mb, p.diff_q_norm, wsp<float>(p, WS_ROPE) + (size_t)SEQ * 32 + (size_t)(qb * 256) * 64, nullptr); }
    if (Mb < SBOUND_MAX) { for (int i = 0; att::attn_next(g, i, bh, qb); i += 2) DIFF_PAIR(true) }
    else { for (int i = 0; att::attn_next(g, i, bh, qb); i += 2) DIFF_PAIR(false) }
#undef DIFF_PAIR
}

__device__ __forceinline__ float wave_sum(float v) {
#pragma unroll
    for (int o = 1; o < 64; o <<= 1) v += __shfl_xor(v, o);
    return v;
}
__device__ __forceinline__ void xn_rows4_wave(const Params& p, int token0, int lane) {
    const f32x4* gr = (const f32x4*)p.attn_norm + lane;
    f32x4 v[4][4]; float s[4];
#pragma unroll
    for (int t = 0; t < 4; ++t) { const f32x4* xr = (const f32x4*)(p.x + (size_t)(token0 + t) * 1024) + lane; s[t] = 0.f;
#pragma unroll
        for (int j = 0; j < 4; ++j) v[t][j] = xr[64 * j]; }
#pragma unroll
    for (int t = 0; t < 4; ++t)
#pragma unroll
        for (int j = 0; j < 4; ++j) s[t] += (v[t][j].x * v[t][j].x + v[t][j].y * v[t][j].y) + (v[t][j].z * v[t][j].z + v[t][j].w * v[t][j].w);
#pragma unroll
    for (int o = 1; o < 64; o <<= 1) {
#pragma unroll
        for (int t = 0; t < 4; ++t) s[t] += __shfl_xor(s[t], o); }
    f32x4 g[4];
#pragma unroll
    for (int j = 0; j < 4; ++j) g[j] = gr[64 * j];
#pragma unroll
    for (int t = 0; t < 4; ++t) { const float rs = 1.0f / sqrtf(s[t] * (1.f / 1024) + EPS);
        unsigned long long* o8 = (unsigned long long*)(wsp<bf16_t>(p, WS_XN) + (size_t)(token0 + t) * 1024) + lane;
#pragma unroll
        for (int j = 0; j < 4; ++j) o8[64 * j] = (unsigned long long)pk2(v[t][j].x * rs * g[j].x, v[t][j].y * rs * g[j].y) | ((unsigned long long)pk2(v[t][j].z * rs * g[j].z, v[t][j].w * rs * g[j].w) << 32);
#if FP8_GATES
        { unsigned* q8 = (unsigned*)(wsp<unsigned char>(p, WS_XN8) + (size_t)(token0 + t) * 1024) + lane; const float s8 = rs * (float)(1 << EXP_T);
#pragma unroll
          for (int j = 0; j < 4; ++j) q8[64 * j] = pk4_e4m3(v[t][j].x * s8 * g[j].x, v[t][j].y * s8 * g[j].y, v[t][j].z * s8 * g[j].z, v[t][j].w * s8 * g[j].w); }
#endif
    }
}
__device__ __forceinline__ void ffn_rstd_wave(const Params& p, int token, int lane) {
    const f32x4* xr = (const f32x4*)(p.out + (size_t)token * 1024) + lane; float s = 0.f;
#pragma unroll
    for (int j = 0; j < 4; ++j) { const f32x4 v = xr[64 * j]; s += (v.x * v.x + v.y * v.y) + (v.z * v.z + v.w * v.w); }
    const float rs = 1.0f / sqrtf(wave_sum(s) * (1.f / 1024) + EPS);
    if (lane == 0) wsp<float>(p, WS_MISC + MS_RSTD)[token] = rs;
}

__device__ __forceinline__ void transpose_tile(const float* W, int N, int k0, int n0, bf16_t* WT, int K, int d0, const float* gain, LAS float* scr, int lane) {
#pragma unroll 16
    for (int i = 0; i < 32; ++i) { const int kk = 2 * i + (lane >> 5); float v = (n0 >= 0) ? W[(size_t)(k0 + kk) * N + n0 + (lane & 31)] : 0.f; if (gain) v *= gain[k0 + kk]; scr[kk * 33 + (lane & 31)] = v; }
    asm volatile("s_waitcnt lgkmcnt(0)" ::: "memory");
    const int cch = lane & 7;
#pragma unroll
    for (int j = 0; j < 4; ++j) { const int n = (lane >> 3) + 8 * j; const LAS float* s = scr + (8 * cch) * 33 + n;
        u32x4 o; o.x = pk2(s[0 * 33], s[1 * 33]); o.y = pk2(s[2 * 33], s[3 * 33]); o.z = pk2(s[4 * 33], s[5 * 33]); o.w = pk2(s[6 * 33], s[7 * 33]);
        *(u32x4*)(WT + (size_t)(d0 + n) * K + k0 + 8 * cch) = o; }
    asm volatile("s_waitcnt lgkmcnt(0)" ::: "memory");
}
__device__ __forceinline__ void transpose_tile8(const float* W, int N, int k0, int n0, unsigned char* WT, int K, int d0, float mul, LAS float* scr, int lane) {
#pragma unroll 16
    for (int i = 0; i < 32; ++i) { const int kk = 2 * i + (lane >> 5); scr[kk * 33 + (lane & 31)] = W[(size_t)(k0 + kk) * N + n0 + (lane & 31)] * mul; }
    asm volatile("s_waitcnt lgkmcnt(0)" ::: "memory");
    const int cch = lane & 7;
#pragma unroll
    for (int j = 0; j < 4; ++j) { const int n = (lane >> 3) + 8 * j; const LAS float* s = scr + (8 * cch) * 33 + n;
        typedef unsigned u2_t __attribute__((ext_vector_type(2))); u2_t o; o.x = pk4_e4m3(s[0 * 33], s[1 * 33], s[2 * 33], s[3 * 33]); o.y = pk4_e4m3(s[4 * 33], s[5 * 33], s[6 * 33], s[7 * 33]);
        *(u2_t*)(WT + (size_t)(d0 + n) * K + k0 + 8 * cch) = o; }
    asm volatile("s_waitcnt lgkmcnt(0)" ::: "memory");
}
constexpr int TI_WIN = 16 * (PROJ_W / 32), TI_WUQ = 12 * 24, TI_WUKV = 4 * 32, TI_WB = 8 * 32, TI_WOUT = 16 * 32, TI_SMALL = TI_WIN + TI_WUQ + TI_WUKV + 2 * TI_WB + TI_WOUT;
__device__ __forceinline__ void smallw_tile(const Params& p, int it, LAS float* scr, int lane) {
    if (it < TI_WIN) { const int kb = it / (PROJ_W / 32), nb = it % (PROJ_W / 32);
        if (FP8_GATES && nb * 32 >= FP8_C0) transpose_tile8(p.w_in, 4640, kb * 64, win_src_col(nb * 32), wsp<unsigned char>(p, WS_WIN8), 1024, nb * 32 - FP8_C0, (float)(1 << EXP_W), scr, lane);
        else transpose_tile(p.w_in, 4640, kb * 64, win_src_col(nb * 32), wsp<bf16_t>(p, WS_WIN), 1024, nb * 32, nullptr, scr, lane); return; } it -= TI_WIN;
    if (it < TI_WUQ) { const int kb = it / 24, nb = it % 24; transpose_tile(p.w_uq, 768, kb * 64, nb * 32, wsp<bf16_t>(p, WS_WUQ), 768, nb * 32, p.q_lat_norm, scr, lane); return; } it -= TI_WUQ;
    if (it < TI_WUKV) { const int kb = it / 32, nb = it % 32; transpose_tile(p.w_ukv, 1024, kb * 64, nb * 32, wsp<bf16_t>(p, WS_WUKV), 256, nb * 32, p.kv_lat_norm, scr, lane); return; } it -= TI_WUKV;
    if (it < TI_WB) { const int kb = it / 32, nb = it % 32; transpose_tile(p.w_ba, 1024, kb * 64, nb * 32, wsp<bf16_t>(p, WS_WBA), 512, nb * 32, nullptr, scr, lane); return; } it -= TI_WB;
    if (it < TI_WB) { const int kb = it / 32, nb = it % 32; transpose_tile(p.w_bb, 1024, kb * 64, nb * 32, wsp<bf16_t>(p, WS_WBB), 512, nb * 32, nullptr, scr, lane); return; } it -= TI_WB;
    { const int kb = it / 32, nb = it % 32; transpose_tile(p.w_out, 1024, kb * 64, nb * 32, wsp<bf16_t>(p, WS_WOUT), 1024, nb * 32, nullptr, scr, lane); }
}
__device__ __forceinline__ void transpose_tile8x(const float* W, int N, int k0, int n0, unsigned char* WT, int K, int d0, float mul, int lane) {
    const int q = lane & 15, g = lane >> 4; const float* src = W + (size_t)(k0 + 16 * g) * N + n0 + 4 * q; f32x4 v[16];
#pragma unroll
    for (int i = 0; i < 16; ++i) v[i] = *(const f32x4*)(src + (size_t)i * N);
#pragma unroll
    for (int j = 0; j < 4; ++j) { u32x4 o;
#pragma unroll
        for (int w = 0; w < 4; ++w) o[w] = pk4_e4m3(v[4 * w][j] * mul, v[4 * w + 1][j] * mul, v[4 * w + 2][j] * mul, v[4 * w + 3][j] * mul);
        *(u32x4*)(WT + (size_t)(d0 + 4 * q + j) * K + k0 + 16 * g) = o; }
}
constexpr int TI_W1 = NE * 16 * 32, TI_W2 = NE * 16 * 16, TI_MOEW = TI_W1 + TI_W2;
__device__ __forceinline__ void moew_tile(const Params& p, int it, LAS float* scr, int lane) {
    if (it < TI_W1) { const int e = it / (16 * 32), r = it % (16 * 32), nb = r / 16, kb = r % 16;
        transpose_tile8x(p.w1 + (size_t)e * 1024 * 2048, 2048, kb * 64, w1_src_col(nb * 64), wsp<unsigned char>(p, WS_W1) + (size_t)e * 2048 * 1024, 1024, nb * 64, (float)(1 << EXP_W), lane); return; }
    it -= TI_W1;
    { const int e = it / (16 * 16), r = it % (16 * 16), nb = r / 16, kb = r % 16;
        transpose_tile8x(p.w2 + (size_t)e * 1024 * 1024, 1024, kb * 64, nb * 64, wsp<unsigned char>(p, WS_W2) + (size_t)e * 1024 * 1024, 1024, nb * 64, (float)(1 << EXP_W), lane); }
}
__device__ __forceinline__ void router_wave(const Params& p, int tok0, int lane) {
    typedef short bf16x8 __attribute__((ext_vector_type(8))); typedef float f32x16 __attribute__((ext_vector_type(16)));
    const int r32 = lane & 31, hi = lane >> 5;
    const float* hrow = p.out + (size_t)(tok0 + r32) * 1024 + 8 * hi;
    const u32x4* wh = wsp<u32x4>(p, WS_WRH) + lane; const u32x4* wl = wsp<u32x4>(p, WS_WRL) + lane;
    f32x16 acc = f32x16{}; float ss = 0.f;
#pragma unroll 4
    for (int s = 0; s < 64; ++s) {
        const f32x4 a0 = *(const f32x4*)(hrow + 16 * s), a1 = *(const f32x4*)(hrow + 16 * s + 4);
        float a[8] = {a0[0], a0[1], a0[2], a0[3], a1[0], a1[1], a1[2], a1[3]}, ah[8], al[8];
#pragma unroll
        for (int j = 0; j < 8; ++j) { ss += a[j] * a[j]; ah[j] = bf2f(f2bf(a[j])); al[j] = a[j] - ah[j]; }
        const bf16x8 fah = __builtin_bit_cast(bf16x8, pack8(ah)), fal = __builtin_bit_cast(bf16x8, pack8(al));
        const bf16x8 fwh = __builtin_bit_cast(bf16x8, wh[64 * s]), fwl = __builtin_bit_cast(bf16x8, wl[64 * s]);
        acc = __builtin_amdgcn_mfma_f32_32x32x16_bf16(fah, fwh, acc, 0, 0, 0);
        acc = __builtin_amdgcn_mfma_f32_32x32x16_bf16(fal, fwh, acc, 0, 0, 0);
        acc = __builtin_amdgcn_mfma_f32_32x32x16_bf16(fah, fwl, acc, 0, 0, 0);
    }
    ss += __shfl_xor(ss, 32);
    const float rs = 1.0f / sqrtf(ss * (1.f / 1024) + EPS);
    if (hi == 0) wsp<float>(p, WS_MISC + MS_RSTD)[tok0 + r32] = rs;
    const float be = p.b_router[r32]; float* lg = wsp<float>(p, WS_LOGIT);
#pragma unroll
    for (int r = 0; r < 16; ++r) { const int row = (r & 3) + 8 * (r >> 2) + 4 * hi; const float rr = __shfl(rs, row); lg[(size_t)(tok0 + row) * NE + r32] = acc[r] * rr + be; }
}
__device__ __forceinline__ void router_wave2(const Params& p, int tok0, int wave, int lane, LAS float* lbuf, LAS int* cnts, int (&idx)[4], int (&rank)[4]) {
    typedef short bf16x8 __attribute__((ext_vector_type(8))); typedef float f32x16 __attribute__((ext_vector_type(16)));
    const int r32 = lane & 31, hi = lane >> 5;
    const bf16_t* hrow = wsp<bf16_t>(p, WS_HB) + (size_t)(tok0 + r32) * 1024 + 8 * hi;
    const u32x4* wh = wsp<u32x4>(p, WS_WRH) + lane; const u32x4* wl = wsp<u32x4>(p, WS_WRL) + lane;
    f32x16 acc = f32x16{}; float ss = 0.f;
    LAS unsigned char* tb = (LAS unsigned char*)lbuf; const float* gn = p.ffn_norm + 8 * hi; unsigned char* Tw = wsp<unsigned char>(p, WS_T) + (size_t)tok0 * 1024;
    for (int s8 = 0; s8 < 8; ++s8) {
#pragma unroll 4
        for (int si = 0; si < 8; ++si) { const int s = s8 * 8 + si;
            const u32x4 aw = *(const u32x4*)(hrow + 16 * s);
            const f32x4 g0 = *(const f32x4*)(gn + 16 * s), g1 = *(const f32x4*)(gn + 16 * s + 4);
            float a[8]; unpack8(aw, a);
#pragma unroll
            for (int j = 0; j < 8; ++j) ss += a[j] * a[j];
            const bf16x8 fah = __builtin_bit_cast(bf16x8, aw);
            const bf16x8 fwh = __builtin_bit_cast(bf16x8, wh[64 * s]), fwl = __builtin_bit_cast(bf16x8, wl[64 * s]);
            acc = __builtin_amdgcn_mfma_f32_32x32x16_bf16(fah, fwh, acc, 0, 0, 0);
            acc = __builtin_amdgcn_mfma_f32_32x32x16_bf16(fah, fwl, acc, 0, 0, 0);
            constexpr float TS = (float)(1 << EXP_T); typedef unsigned u2_t __attribute__((ext_vector_type(2)));
#define T8C(x) __builtin_amdgcn_fmed3f((x), -448.0f, 448.0f)
            u2_t w; w.x = pk4_e4m3(T8C(a[0] * g0[0] * TS), T8C(a[1] * g0[1] * TS), T8C(a[2] * g0[2] * TS), T8C(a[3] * g0[3] * TS)); w.y = pk4_e4m3(T8C(a[4] * g1[0] * TS), T8C(a[5] * g1[1] * TS), T8C(a[6] * g1[2] * TS), T8C(a[7] * g1[3] * TS));
#undef T8C
            *(LAS u2_t*)(tb + r32 * 144 + si * 16 + hi * 8) = w; }
        asm volatile("s_waitcnt lgkmcnt(0)" ::: "memory");
#pragma unroll
        for (int i = 0; i < 4; ++i) { const int q = lane + 64 * i, row = q >> 3, part = q & 7;
            const u32x4 w = *(const LAS u32x4*)(tb + row * 144 + part * 16);
            *(u32x4*)(Tw + (size_t)row * 1024 + s8 * 128 + part * 16) = w; }
        asm volatile("s_waitcnt lgkmcnt(0)" ::: "memory");
    }
    ss += __shfl_xor(ss, 32);
    const float rs = 1.0f / sqrtf(ss * (1.f / 1024) + EPS);
    if (hi == 0) wsp<float>(p, WS_MISC + MS_RSTD)[tok0 + r32] = rs;
    const float be = p.b_router[r32];
#pragma unroll
    for (int r = 0; r < 16; ++r) { const int row = (r & 3) + 8 * (r >> 2) + 4 * hi; const float rr = __shfl(rs, row); lbuf[row * 33 + r32] = acc[r] * rr + be; }
    asm volatile("s_waitcnt lgkmcnt(0)" ::: "memory");
    float v[NE];
#pragma unroll
    for (int e = 0; e < NE; ++e) v[e] = lbuf[r32 * 33 + e];
    float val[4];
#pragma unroll
    for (int k = 0; k < 4; ++k) { int bi = 0; float bv = -INFINITY;
#pragma unroll
        for (int e = 0; e < NE; ++e) { const bool taken = (k > 0 && idx[0] == e) || (k > 1 && idx[1] == e) || (k > 2 && idx[2] == e); if (!taken && v[e] > bv) { bv = v[e]; bi = e; } }
        idx[k] = bi; val[k] = bv; }
    const float m = val[0]; float ex[4], sum = 0.f;
#pragma unroll
    for (int k = 0; k < 4; ++k) { ex[k] = expf(val[k] - m); sum += ex[k]; }
    if (hi == 0) { typedef int i32x4 __attribute__((ext_vector_type(4)));
        *(i32x4*)(wsp<int>(p, WS_TOPI) + (size_t)(tok0 + r32) * 4) = (i32x4){idx[0], idx[1], idx[2], idx[3]};
        *(f32x4*)(wsp<float>(p, WS_TOPW) + (size_t)(tok0 + r32) * 4) = (f32x4){ex[0] / sum, ex[1] / sum, ex[2] / sum, ex[3] / sum}; }
    const unsigned below = (1u << r32) - 1u; int mycnt = 0;
#pragma unroll
    for (int k = 0; k < 4; ++k) rank[k] = 0;
#pragma unroll 1
    for (int e = 0; e < NE; ++e) {
        const unsigned b0 = (unsigned)__ballot(idx[0] == e), b1 = (unsigned)__ballot(idx[1] == e), b2 = (unsigned)__ballot(idx[2] == e), b3 = (unsigned)__ballot(idx[3] == e);
        const int ce = __builtin_popcount(b0) + __builtin_popcount(b1) + __builtin_popcount(b2) + __builtin_popcount(b3);
        const int lo = __builtin_popcount(b0 & below) + __builtin_popcount(b1 & below) + __builtin_popcount(b2 & below) + __builtin_popcount(b3 & below);
#pragma unroll
        for (int k = 0; k < 4; ++k) if (idx[k] == e) rank[k] = lo;
        if (r32 == e) mycnt = ce; }
    if (hi == 0) cnts[wave * 32 + r32] = mycnt;
}
__device__ __forceinline__ void router_finish(const Params& p, int tok0, int chunk, int wave, int lane, const LAS int* cnts, const int (&idx)[4], int (&rank)[4]) {
    if (lane < 32) {
        for (int w = 0; w < wave; ++w) {
#pragma unroll
            for (int k = 0; k < 4; ++k) rank[k] += cnts[w * 32 + idx[k]]; }
        typedef int i32x4 __attribute__((ext_vector_type(4)));
        *(i32x4*)(wsp<int>(p, WS_SLOT) + (size_t)(tok0 + lane) * 4) = (i32x4){rank[0], rank[1], rank[2], rank[3]};
        if (wave == 0) { int s = 0;
#pragma unroll
            for (int w = 0; w < NWAVES; ++w) s += cnts[w * 32 + lane];
            wsp<int>(p, WS_MISC + MS_CHUNKCNT)[chunk * 32 + lane] = s; } }
}
__device__ __forceinline__ void post_rstd_wave(const Params& p, int token, int lane, float& rq, float& rkv) {
    const bf16_t* proj = wsp<bf16_t>(p, WS_PROJ) + (size_t)token * PROJ_W; float v[8]; float sq = 0.f, sk = 0.f;
    load8(proj + PC_QLAT + lane * 8, v);
#pragma unroll
    for (int j = 0; j < 8; ++j) sq += v[j] * v[j];
    if (lane < 32) { load8(proj + PC_QLAT + 512 + lane * 8, v);
#pragma unroll
        for (int j = 0; j < 8; ++j) sq += v[j] * v[j];
        load8(proj + PC_KVLAT + lane * 8, v);
#pragma unroll
        for (int j = 0; j < 8; ++j) sk += v[j] * v[j]; }
    rq = 1.0f / sqrtf(wave_sum(sq) * (1.f / QLORA) + EPS); rkv = 1.0f / sqrtf(wave_sum(sk) * (1.f / KVLORA) + EPS);
}

__device__ __forceinline__ void post_tokens2_wave(const Params& p, int tokA, int lane, LAS float* bufA) {
    const int hd = lane >> 3, part = lane & 7;
    bf16_t* proj[2]; bf16_t* kvr[2]; const float* tab_mla[2]; const float* tab_diff[2]; LAS float* buf[2] = {bufA, bufA + 768};
#pragma unroll
    for (int t = 0; t < 2; ++t) { const int token = tokA + t, pos = token % SEQ; proj[t] = wsp<bf16_t>(p, WS_PROJ) + (size_t)token * PROJ_W; kvr[t] = wsp<bf16_t>(p, WS_KV) + (size_t)token * KV_W;
        tab_mla[t] = wsp<float>(p, WS_ROPE) + (size_t)pos * 32; tab_diff[t] = wsp<float>(p, WS_ROPE) + (size_t)SEQ * 32 + (size_t)pos * 64; }
    u32x4 wkn[2], wkp[2], wdk[2]; float ssq[2];
#pragma unroll
    for (int t = 0; t < 2; ++t) { ssq[t] = wsp<float>(p, WS_SSP)[(size_t)(tokA + t) * 16 + (lane & 15)];
        wkn[t] = *(const u32x4*)(kvr[t] + hd * 160 + part * 8); wkp[t] = *(const u32x4*)(proj[t] + PC_KPE + (part & 3) * 8);
        wdk[t] = *(const u32x4*)(proj[t] + PC_DK + hd * 64 + part * 8); }
    float rq[2];
#pragma unroll
    for (int t = 0; t < 2; ++t) { float sq = (lane & 15) < 12 ? ssq[t] : 0.f; sq += __shfl_xor(sq, 1); sq += __shfl_xor(sq, 2); sq += __shfl_xor(sq, 4); sq += __shfl_xor(sq, 8);
        rq[t] = 1.0f / sqrtf(sq * (1.f / QLORA) + EPS); if (lane == 0) wsp<float>(p, WS_MISC + MS_RQ)[tokA + t] = rq[t]; }
#pragma unroll
    for (int t = 0; t < 2; ++t) { float v[8]; unpack8(wkn[t], v);
#pragma unroll
        for (int j = 0; j < 8; ++j) buf[t][(hd * 12 + part) * 8 + j] = v[j];
        if (part < 4) { unpack8(wkp[t], v);
#pragma unroll
            for (int j = 0; j < 8; ++j) buf[t][(hd * 12 + 8 + part) * 8 + j] = v[j]; } }
    asm volatile("s_waitcnt lgkmcnt(0)" ::: "memory");
    float rsk[2];
#pragma unroll
    for (int t = 0; t < 2; ++t) { float ss = 0.f;
#pragma unroll
        for (int j = 0; j < 12; ++j) { const float x = buf[t][hd * 96 + part * 12 + j]; ss += x * x; }
        rsk[t] = ss; }
#pragma unroll
    for (int o = 1; o < 8; o <<= 1) { rsk[0] += __shfl_xor(rsk[0], o); rsk[1] += __shfl_xor(rsk[1], o); }
#pragma unroll
    for (int t = 0; t < 2; ++t) rsk[t] = 1.0f / sqrtf(rsk[t] * (1.0f / 96) + EPS);
    const float* gain = p.mla_k_norm;
#pragma unroll
    for (int i = 0; i < 2; ++i) { const int c = lane + 64 * i; const int cv = c < 96 ? c : 0; const int hc = cv / 12, cc = cv % 12;
#pragma unroll
        for (int t = 0; t < 2; ++t) { const float rs = __shfl(rsk[t], hc * 8); float o[8];
            if (cc < 8) {
#pragma unroll
                for (int j = 0; j < 8; ++j) o[j] = buf[t][cv * 8 + j] * rs * gain[cc * 8 + j];
            } else { const bool first = cc < 10; const int ccp = first ? cc + 2 : cc - 2;
#pragma unroll
                for (int j = 0; j < 8; ++j) { const float a = buf[t][cv * 8 + j] * rs * gain[cc * 8 + j], b = buf[t][(hc * 12 + ccp) * 8 + j] * rs * gain[ccp * 8 + j];
                    const int fi = (cc & 1) * 8 + j; const float cs = tab_mla[t][2 * fi], sn = tab_mla[t][2 * fi + 1]; o[j] = first ? a * cs - b * sn : a * cs + b * sn; } }
            if (c < 96) store8(kvr[t] + hc * 160 + cc * 8, o); } }
    float dkv[2][8], dss[2];
#pragma unroll
    for (int t = 0; t < 2; ++t) { unpack8(wdk[t], dkv[t]); float ss = 0.f;
#pragma unroll
        for (int j = 0; j < 8; ++j) ss += dkv[t][j] * dkv[t][j];
        dss[t] = ss; }
#pragma unroll
    for (int o = 1; o < 8; o <<= 1) { dss[0] += __shfl_xor(dss[0], o); dss[1] += __shfl_xor(dss[1], o); }
    { const float* dg = p.diff_k_norm; const bool first = part < 4; const int pp = part ^ 4;
#pragma unroll
      for (int t = 0; t < 2; ++t) { const float rs = 1.0f / sqrtf(dss[t] * (1.0f / 64) + EPS); float o[8];
#pragma unroll
          for (int j = 0; j < 8; ++j) { const float a = dkv[t][j] * rs * dg[part * 8 + j]; const float b = __shfl_xor(dkv[t][j], 4) * rs * dg[pp * 8 + j];
              const int fi = (part & 3) * 8 + j; const float cs = tab_diff[t][2 * fi], sn = tab_diff[t][2 * fi + 1]; o[j] = first ? a * cs - b * sn : a * cs + b * sn; }
          store8(proj[t] + PC_DK + hd * 64 + part * 8, o); } }
    asm volatile("s_waitcnt lgkmcnt(0)" ::: "memory");
}

constexpr int N_PHASES = 19;
__global__ void __launch_bounds__(NTHREADS, 2) fwd(Params p) {
    extern __shared__ __attribute__((aligned(16))) unsigned char lds_raw[];
    LAS unsigned char* lds = (LAS unsigned char*)lds_raw;
    volatile LAS unsigned* MISC = (volatile LAS unsigned*)(lds + MISC_OFF);
    const int G = gridDim.x, c = blockIdx.x;
    const GridPos gp{G, c};
    const long gthreads = (long)G * NTHREADS; const int gwaves = G * NWAVES;
#define TIDS() int tid = threadIdx.x; asm volatile("" : "+v"(tid)); const int lane = tid & 63, wave = __builtin_amdgcn_readfirstlane(tid >> 6); const long gtid = (long)c * NTHREADS + tid; const int gwave = c * NWAVES + wave; (void)lane; (void)gtid; (void)gwave
    for (int u = threadIdx.x; u < (LDS_BYTES - RING_BYTES) / 4; u += NTHREADS) ((LAS unsigned*)(lds + RING_BYTES))[u] = 0u;
    __syncthreads();
    unsigned* ctl = wsp<unsigned>(p, WS_CTL);
#if ONE_LAUNCH
    XcdBarrier bar = xcd_barrier_post(ctl + CW_BAR, MISC + 8);
#define GRID_BAR() xcd_barrier(bar)
#else
#define GRID_BAR() do { } while (0)
#endif
    const int lo = p.ph_lo, hi = p.ph_hi;
#define IN(k) (lo <= (k) && (k) < hi)
#define SEAM(k) do { if (IN(k) && IN((k) + 1)) GRID_BAR(); } while (0)

#define REPEAT(k, BODY) do { if constexpr (((PROBE_MASK) >> (k)) & 1u) { if (IN((k) >= 20 ? 9 : (k))) { GRID_BAR(); BODY } } } while (0)
#define PH0 { TIDS(); LAS float* scr = (LAS float*)(lds + wave * 8448); for (int it = gwave; it < TI_SMALL; it += gwaves) smallw_tile(p, it, scr, lane); \
        for (long it = gtid; it < IT_ROPE; it += gthreads) rope_tab_item(p, (int)it); for (long it = gtid; it < 64 * 64; it += gthreads) wr_frag_item(p, (int)it); \
        if (gtid == 0) { lambda_item(p); sbound_item(p); } for (int t = gwave * 4; t < NTOK; t += gwaves * 4) xn_rows4_wave(p, t, lane); }
    if (IN(0)) PH0; REPEAT(0, PH0); SEAM(0);
#if FP8_GATES
#define PH1 { { const ProbInProj pr = mk_inproj(p, gp); run_gemm(lds, pr, p.ws); } { const ProbInProjG pr = mk_inprojg(p, gp); run_gemm(lds, pr, p.ws); } }
#else
#define PH1 { const ProbInProj pr = mk_inproj(p, gp); run_gemm(lds, pr, p.ws); }
#endif
    if (IN(1)) PH1; REPEAT(1, PH1);
#if GEMM_EXPERIMENT >= 0
    if (IN(1)) { GRID_BAR(); ProbInProj pr = mk_inproj(p, gp); pr.P = wsp<bf16_t>(p, 960 * MiB) - (size_t)0; struct Dmy : ProbInProj { HD void epi(const Acc& acc, const Unit& u, int wr, int wc, int fr, int fq) const { Unit v = u; v.row0 = u.row0 & 255 ? 0 : 0; ProbInProj::epi(acc, v, wr, wc, fr, fq); } };
        Dmy dm; *(ProbInProj*)&dm = pr; if constexpr (GEMM_EXPERIMENT >= 20) pg8::gemm_phase_pipe2<Dmy, GEMM_EXPERIMENT - 20>(lds, dm, p.ws); else if constexpr (GEMM_EXPERIMENT >= 10) pg8::gemm_phase_pipe<Dmy, GEMM_EXPERIMENT - 10>(lds, dm, p.ws); else pg8::gemm_phase<Dmy, GEMM_EXPERIMENT < 10 ? GEMM_EXPERIMENT : 0>(lds, dm, p.ws); }
#endif
    SEAM(1);
#define PH2 { { const ProbUpQ pr = mk_upq(p, gp); run_gemm(lds, pr, p.ws); } { const ProbUpKV pr = mk_upkv(p, gp); run_gemm(lds, pr, p.ws); } }
#ifndef SKEW2_SLEEPS
#define SKEW2_SLEEPS 3
#endif
    if (IN(2)) { if ((c >> 3) & 1) { for (int s_ = 0; s_ < SKEW2_SLEEPS; ++s_) __builtin_amdgcn_s_sleep(127); } PH2; } REPEAT(2, PH2); SEAM(2);
    if (IN(3)) { TIDS(); LAS float* buf = (LAS float*)(lds + wave * 8192);
        for (int t = gwave * 2; t < NTOK; t += gwaves * 2) post_tokens2_wave(p, t, lane, buf); }
    SEAM(3);
#if USE_MFMA_ATTN
#define PH4 { attn_mla_phase(lds, p, gp); }
#define PH5 { attn_diff_phase(lds, p, gp); }
#else
#define PH4 { }
#define PH5 { }
#endif
    if (IN(4)) PH4;
#if ATTN_EXPERIMENT >= 0
    if (IN(4)) { GRID_BAR(); int bh, qb;
        for (int i = 0; att::attn_next(gp, i, bh, qb); ++i) { const int b = bh >> 3, h = bh & 7; const size_t tok0 = (size_t)b * SEQ, row0 = tok0 + (size_t)qb * 256;
            att::attn_unit<96, 64, ATTN_EXPERIMENT>(lds, wsp<bf16_t>(p, WS_QA) + row0 * QA_W + h * 96, QA_W, wsp<bf16_t>(p, WS_KV) + tok0 * KV_W + h * 160, KV_W, wsp<bf16_t>(p, WS_KV) + tok0 * KV_W + h * 160 + 96, KV_W,
                                   wsp<bf16_t>(p, 960 * MiB) + (size_t)(c * 256) * 512 + h * 64, 512, qb * 256); } }
#endif
    if (IN(5)) PH5; SEAM(5);
#define PH7 { const ProbBranch pr = mk_branch(p, gp); run_gemm(lds, pr, p.ws); }
    if (IN(7)) PH7; REPEAT(7, PH7); SEAM(7);
#define PH8 { const ProbOut pr = mk_out(p, gp); run_gemm(lds, pr, p.ws); }
    if (IN(8)) PH8; REPEAT(8, PH8); SEAM(8);
#define PH9 { TIDS(); LAS float* lbuf = (LAS float*)(lds + wave * 4608); LAS int* cnts = (LAS int*)(lds + NWAVES * 4608); \
        for (int chunk = c; chunk < NCHUNK; chunk += G) { const int t0 = chunk * CHUNK; int idx[4], rank[4]; \
            router_wave2(p, t0 + wave * 32, wave, lane, lbuf, cnts, idx, rank); \
            __syncthreads(); \
            router_finish(p, t0 + wave * 32, chunk, wave, lane, cnts, idx, rank); \
            __syncthreads(); } }
#define PH9W { TIDS(); __syncthreads(); LAS float* scr = (LAS float*)(lds + wave * 8448); for (int it = gwave; it < TI_MOEW; it += gwaves) moew_tile(p, it, scr, lane); }
    if (IN(9)) { PH9; } REPEAT(9, PH9);
    SEAM(9);
#define PH10 { TIDS(); \
        LAS int* cc = (LAS int*)lds;                                   \
        LAS int* tot = cc + NCHUNK * 32;                               \
        LAS int* ebs = tot + 64; \
        const int* gcc = wsp<int>(p, WS_MISC + MS_CHUNKCNT); \
        for (int i = tid; i < NCHUNK * 32; i += NTHREADS) cc[i] = gcc[i]; \
        __syncthreads(); \
        if (tid < NHALF * 32) { const int hf = tid >> 5, e = tid & 31; int s = 0; for (int ch = hf * CHUNK_PER_HALF; ch < (hf + 1) * CHUNK_PER_HALF; ++ch) s += cc[ch * 32 + e]; tot[tid] = s; } \
        __syncthreads(); \
        if (tid < NHALF * 32) { const int hf = tid >> 5, e = tid & 31; int s = 0; for (int e2 = 0; e2 < e; ++e2) s += tot[hf * 32 + e2]; ebs[tid] = s; } \
        __syncthreads(); \
        if (c == 0 && tid < NHALF) {                                       \
            const int hf = tid; int* eb = wsp<int>(p, WS_MISC + MS_EBASE); int* nt = wsp<int>(p, WS_MISC + MS_NTILES); int* tl = wsp<int>(p, WS_MISC + MS_TILES); int n = 0; \
            for (int e = 0; e < NE; ++e) { const int cnt = tot[hf * 32 + e], run = ebs[hf * 32 + e]; eb[hf * 33 + e] = run; \
                for (int r = 0; r < cnt; r += 256) { int* t = tl + ((size_t)hf * MAX_TILES + n) * 4; t[0] = e; t[1] = run + r; t[2] = (cnt - r) < 256 ? (cnt - r) : 256; t[3] = 0; ++n; } } \
            nt[hf] = n; } \
        LAS int* pre = ebs + 64; \
        for (int chunk = c; chunk < NCHUNK; chunk += G) { const int hf = chunk / CHUNK_PER_HALF; \
            __syncthreads(); \
            if (tid < 32) { int s = ebs[hf * 32 + tid]; for (int ch = hf * CHUNK_PER_HALF; ch < chunk; ++ch) s += cc[ch * 32 + tid]; pre[tid] = s; } \
            __syncthreads(); \
            for (int it = tid; it < CHUNK * 4; it += NTHREADS) { const long item = (long)chunk * CHUNK * 4 + it; const int token = (int)(item >> 2); const int e = wsp<int>(p, WS_TOPI)[item]; \
                const int slot = pre[e] + wsp<int>(p, WS_SLOT)[item];            \
                wsp<int>(p, WS_SLOT)[item] = slot; wsp<int>(p, WS_TOKOF)[(size_t)hf * HALF_SLOTS + slot] = token; wsp<float>(p, WS_WOF)[(size_t)hf * HALF_SLOTS + slot] = wsp<float>(p, WS_TOPW)[item]; wsp<float>(p, WS_RSOF)[(size_t)hf * HALF_SLOTS + slot] = wsp<float>(p, WS_MISC + MS_RSTD)[token]; } } \
        __syncthreads(); \
        LAS float* scr = (LAS float*)(lds + wave * 8448); for (int it = gwave; it < TI_MOEW; it += gwaves) moew_tile(p, it, scr, lane); \
    }
    if (IN(10)) PH10; REPEAT(10, PH10);
    SEAM(10);
#define PH12 { const ProbMoe1 pr = mk_moe1(p, gp, 0); run_gemm(lds, pr, p.ws); }
#define PH13 { const ProbMoe2 pr = mk_moe2(p, gp, 0); run_gemm(lds, pr, p.ws); }
#if CFG_NHALF == 2
#define PH15 { const ProbMoe1 pr = mk_moe1(p, gp, 1); run_gemm(lds, pr, p.ws); }
#define PH16 { const ProbMoe2 pr = mk_moe2(p, gp, 1); run_gemm(lds, pr, p.ws); }
#endif
    if (IN(12)) PH12; REPEAT(12, PH12); SEAM(12);
    if (IN(13)) PH13; REPEAT(13, PH13); SEAM(13);
    if (IN(14)) { { TIDS(); for (long it = gtid; it < (long)HALF_TOK * 128; it += gthreads) final_item(p, 0, it); }
#if CFG_NHALF == 2
        PH15;
#endif
    }
#if CFG_NHALF == 2
    SEAM(14);
    if (IN(16)) PH16; REPEAT(16, PH16); SEAM(16);
    if (IN(17)) { TIDS(); for (long it = gtid; it < (long)HALF_TOK * 128; it += gthreads) final_item(p, 1, it); }
#endif
#undef IN
#undef SEAM
}

extern "C" void kernel_launch(void* const* d_in, const int* in_sizes, int n_in, void* d_out, int out_size, void* d_ws, size_t ws_size, hipStream_t stream) {
    static int grid = 0;
    if (grid == 0) {
        if (n_in != 26 || in_sizes[0] != NTOK * 1024 || out_size != NTOK * 1024 || ws_size < WS_END) {
            fprintf(stderr, "kernel_launch: unexpected shapes: n_in %d in0 %d out %d ws %zu (need %zu)\n", n_in, n_in > 0 ? in_sizes[0] : -1, out_size, ws_size, (size_t)WS_END); grid = -1; return; }
        int dev = 0, cus = 0;
        if (hipGetDevice(&dev) != hipSuccess || hipDeviceGetAttribute(&cus, hipDeviceAttributeMultiprocessorCount, dev) != hipSuccess) { grid = -1; return; }
        if (hipFuncSetAttribute((const void*)fwd, hipFuncAttributeMaxDynamicSharedMemorySize, LDS_BYTES) != hipSuccess) { fprintf(stderr, "kernel_launch: hipFuncSetAttribute failed\n"); grid = -1; return; }
        int per_cu = 0;
        if (hipOccupancyMaxActiveBlocksPerMultiprocessor(&per_cu, (const void*)fwd, NTHREADS, LDS_BYTES) != hipSuccess || per_cu < 1) fprintf(stderr, "kernel_launch: occupancy query reports %d\n", per_cu);
        (void)hipGetLastError();
        grid = cus;
    }
    if (grid < 0) return;
    (void)hipMemsetAsync((char*)d_ws + WS_CTL, 0, 1 * MiB, stream);
    Params p{};
    const float** f = (const float**)&p;
    for (int i = 0; i < 26; ++i) f[i] = (const float*)d_in[i];
    p.out = (float*)d_out; p.ws = (unsigned char*)d_ws;
#if ONE_LAUNCH
    p.ph_lo = 0; p.ph_hi = N_PHASES;
    hipLaunchKernelGGL(fwd, dim3(grid), dim3(NTHREADS), LDS_BYTES, stream, p);
#else
    for (int ph = 0; ph < 18; ++ph) {
        p.ph_lo = ph; p.ph_hi = ph + 1;
#if !USE_MFMA_GEMM
        if (ph == 1) { hipLaunchKernelGGL(ref_gemm_kernel<1>, dim3(grid), dim3(NTHREADS), 0, stream, p); continue; }
        if (ph == 2) { hipLaunchKernelGGL(ref_gemm_kernel<2>, dim3(grid), dim3(NTHREADS), 0, stream, p); hipLaunchKernelGGL(ref_gemm_kernel<3>, dim3(grid), dim3(NTHREADS), 0, stream, p); continue; }
        if (ph == 7) { hipLaunchKernelGGL(ref_gemm_kernel<7>, dim3(grid), dim3(NTHREADS), 0, stream, p); continue; }
        if (ph == 8) { hipLaunchKernelGGL(ref_gemm_kernel<8>, dim3(grid), dim3(NTHREADS), 0, stream, p); continue; }
        if (ph == 12) { hipLaunchKernelGGL(ref_gemm_kernel<12>, dim3(grid), dim3(NTHREADS), 0, stream, p); continue; }
        if (ph == 13) { hipLaunchKernelGGL(ref_gemm_kernel<13>, dim3(grid), dim3(NTHREADS), 0, stream, p); continue; }
        if (ph == 15) { hipLaunchKernelGGL(ref_gemm_kernel<15>, dim3(grid), dim3(NTHREADS), 0, stream, p); continue; }
        if (ph == 16) { hipLaunchKernelGGL(ref_gemm_kernel<16>, dim3(grid), dim3(NTHREADS), 0, stream, p); continue; }
#endif
#if !USE_MFMA_ATTN
        if (ph == 4) { hipLaunchKernelGGL(ref_attn_kernel<4>, dim3(grid * 8), dim3(256), 0, stream, p); continue; }
        if (ph == 5) { hipLaunchKernelGGL(ref_attn_kernel<5>, dim3(grid * 8), dim3(256), 0, stream, p); continue; }
#endif
        hipLaunchKernelGGL(fwd, dim3(grid), dim3(NTHREADS), LDS_BYTES, stream, p);
    }
#endif
}
```

```cpp
#include <hip/hip_runtime.h>
#include <cstdio>
#include <cstdint>
#include <cmath>

#ifndef CFG_B
#define CFG_B 8
#endif
#ifndef CFG_S
#define CFG_S 8192
#endif
#ifndef USE_MFMA_GEMM
#define USE_MFMA_GEMM 1
#endif
#ifndef USE_MFMA_ATTN
#define USE_MFMA_ATTN 1
#endif
#ifndef ONE_LAUNCH
#define ONE_LAUNCH 1
#endif

#ifndef GEMM_PIPE
#define GEMM_PIPE 0
#endif
#ifndef FP8_GATES
#define FP8_GATES 1
#endif
#ifndef FP8_INPROJ
#define FP8_INPROJ 0
#endif
#ifndef ATTN_EXPERIMENT
#define ATTN_EXPERIMENT -1
#endif
#ifndef GEMM_EXPERIMENT
#define GEMM_EXPERIMENT -1
#endif
#ifndef PROBE_MASK
#define PROBE_MASK 0u
#endif

#define HD __host__ __device__ __forceinline__

constexpr int D_MODEL = 1024, BATCH = CFG_B, SEQ = CFG_S, NTOK = BATCH * SEQ;
constexpr int MLA_H = 8, QK = 96, QLORA = 768, KVLORA = 256;
constexpr int NE = 32, TOPK = 4;
constexpr float EPS = 1e-6f;
constexpr float LAMBDA_INIT = 0.2f;
constexpr float QSCALE_MLA = 0.10206207261596575f * 1.4426950408889634f, QSCALE_DIFF = 0.125f * 1.4426950408889634f;
constexpr float LN2 = 0.6931471805599453f;
constexpr int PC_QLAT = 0, PC_KVLAT = 768, PC_KPE = 1024, PC_DQ = 1280, PC_DK = 1792, PC_DV = 2304, PC_GA = 2816, PC_GB = 3840, PROJ_W = 4864;
constexpr int QA_W = 768;
constexpr int KV_W = 1280;
constexpr int OD_W = 1024;
#ifndef CFG_NHALF
#define CFG_NHALF 1
#endif
constexpr int NHALF = CFG_NHALF;
constexpr int HALF_TOK = NTOK / NHALF, HALF_SLOTS = HALF_TOK * TOPK;
constexpr int CHUNK = 256, NCHUNK = NTOK / CHUNK, CHUNK_PER_HALF = NCHUNK / NHALF;
constexpr int MAX_TILES = HALF_SLOTS / 256 + NE;

typedef unsigned short bf16_t;
typedef float f32x4 __attribute__((ext_vector_type(4)));
typedef unsigned u32x4 __attribute__((ext_vector_type(4)));

HD float bf2f(bf16_t v) { return __builtin_bit_cast(float, (unsigned)v << 16); }
#if defined(__HIP_DEVICE_COMPILE__)
HD unsigned pk2(float lo, float hi) { typedef float f2_t __attribute__((ext_vector_type(2))); typedef __bf16 b2_t __attribute__((ext_vector_type(2))); const f2_t v = {lo, hi}; return __builtin_bit_cast(unsigned, __builtin_convertvector(v, b2_t)); }
HD bf16_t f2bf(float f) { return (bf16_t)(pk2(f, 0.f) & 0xffffu); }
HD float sigmoidf_(float x) { return __builtin_amdgcn_rcpf(1.f + __builtin_amdgcn_exp2f(-1.4426950408889634f * x)); }
#else
HD bf16_t f2bf(float f) { unsigned u = __builtin_bit_cast(unsigned, f); return (bf16_t)((u + 0x7fffu + ((u >> 16) & 1u)) >> 16); }
HD unsigned pk2(float lo, float hi) { return (unsigned)f2bf(lo) | ((unsigned)f2bf(hi) << 16); }
HD float sigmoidf_(float x) { return 1.f / (1.f + expf(-x)); }
#endif
constexpr int EXP_T = 4, EXP_ACT = 2, EXP_W = 9, EXP_Y = 4;
HD unsigned char f2e4m3_sw(float f) {
    const unsigned u = __builtin_bit_cast(unsigned, f); const unsigned sign = (u >> 24) & 0x80u; float a = __builtin_bit_cast(float, u & 0x7fffffffu);
    if (!(a < 448.f)) return (unsigned char)(sign | 0x7e);
    if (a < 0.0009765625f) return (unsigned char)sign;
    int e; (void)frexpf(a, &e); e -= 1;
    if (e < -6) e = -6;
    const float q = ldexpf(1.f, e - 3); const float r = rintf(a / q);
    int m = (int)r;
    if (e == -6 && m < 8) return (unsigned char)(sign | m);
    if (m == 16) { m = 8; e += 1; }
    if (e > 8 || (e == 8 && m > 14)) return (unsigned char)(sign | 0x7e);
    return (unsigned char)(sign | ((e + 7) << 3) | (m - 8));
}
HD float e4m32f(unsigned char b) {
    const int e = (b >> 3) & 15, m = b & 7; float v = e == 0 ? ldexpf((float)m, -9) : ldexpf((float)(8 + m), e - 10);
    return (b & 0x80) ? -v : v;
}
HD unsigned pk4_e4m3(float a, float b, float cc, float d) {
#if defined(__HIP_DEVICE_COMPILE__)
    int w = __builtin_amdgcn_cvt_pk_fp8_f32(a, b, 0, false); w = __builtin_amdgcn_cvt_pk_fp8_f32(cc, d, w, true); return (unsigned)w;
#else
    return (unsigned)f2e4m3_sw(a) | ((unsigned)f2e4m3_sw(b) << 8) | ((unsigned)f2e4m3_sw(cc) << 16) | ((unsigned)f2e4m3_sw(d) << 24);
#endif
}
HD void load8_e4m3(const unsigned char* p, float* v, float mul) { typedef unsigned u2_t __attribute__((ext_vector_type(2))); const u2_t w = *(const u2_t*)p;
#if defined(__HIP_DEVICE_COMPILE__)
    typedef float f2_t __attribute__((ext_vector_type(2)));
    const f2_t a = __builtin_amdgcn_cvt_pk_f32_fp8((int)w.x, false), b = __builtin_amdgcn_cvt_pk_f32_fp8((int)w.x, true), cc = __builtin_amdgcn_cvt_pk_f32_fp8((int)w.y, false), d = __builtin_amdgcn_cvt_pk_f32_fp8((int)w.y, true);
    v[0] = a[0] * mul; v[1] = a[1] * mul; v[2] = b[0] * mul; v[3] = b[1] * mul; v[4] = cc[0] * mul; v[5] = cc[1] * mul; v[6] = d[0] * mul; v[7] = d[1] * mul;
#else
    for (int j = 0; j < 4; ++j) { v[j] = e4m32f((unsigned char)(w.x >> (8 * j))) * mul; v[4 + j] = e4m32f((unsigned char)(w.y >> (8 * j))) * mul; }
#endif
}
HD void store8_e4m3(unsigned char* p, const float* v, float mul) { typedef unsigned u2_t __attribute__((ext_vector_type(2))); u2_t w; w.x = pk4_e4m3(v[0] * mul, v[1] * mul, v[2] * mul, v[3] * mul); w.y = pk4_e4m3(v[4] * mul, v[5] * mul, v[6] * mul, v[7] * mul); *(u2_t*)p = w; }
HD void unpack8(const u32x4 w, float* v) {
    v[0] = __builtin_bit_cast(float, w.x << 16); v[1] = __builtin_bit_cast(float, w.x & 0xffff0000u);
    v[2] = __builtin_bit_cast(float, w.y << 16); v[3] = __builtin_bit_cast(float, w.y & 0xffff0000u);
    v[4] = __builtin_bit_cast(float, w.z << 16); v[5] = __builtin_bit_cast(float, w.z & 0xffff0000u);
    v[6] = __builtin_bit_cast(float, w.w << 16); v[7] = __builtin_bit_cast(float, w.w & 0xffff0000u);
}
HD u32x4 pack8(const float* v) { u32x4 w; w.x = pk2(v[0], v[1]); w.y = pk2(v[2], v[3]); w.z = pk2(v[4], v[5]); w.w = pk2(v[6], v[7]); return w; }
HD void load8(const bf16_t* p, float* v) { unpack8(*(const u32x4*)p, v); }
HD void store8(bf16_t* p, const float* v) { *(u32x4*)p = pack8(v); }
HD void pack8_gate(const float* v, unsigned& lo, unsigned& hi) { unsigned q[8];
#pragma unroll
    for (int j = 0; j < 8; ++j) q[j] = (unsigned)fminf(fmaxf(rintf(v[j] * 255.0f), 1.0f), 255.0f);
    lo = q[0] | (q[1] << 8) | (q[2] << 16) | (q[3] << 24); hi = q[4] | (q[5] << 8) | (q[6] << 16) | (q[7] << 24); }
HD void store8_gate(unsigned char* p, const float* v) { typedef unsigned u2_t __attribute__((ext_vector_type(2))); unsigned lo, hi; pack8_gate(v, lo, hi); u2_t w; w.x = lo; w.y = hi; *(u2_t*)p = w; }
HD void load8_gate(const unsigned char* p, float* v) { typedef unsigned u2_t __attribute__((ext_vector_type(2))); const u2_t w = *(const u2_t*)p;
#pragma unroll
    for (int j = 0; j < 4; ++j) { v[j] = (float)((w.x >> (8 * j)) & 255u) * (1.0f / 255.0f); v[4 + j] = (float)((w.y >> (8 * j)) & 255u) * (1.0f / 255.0f); } }

constexpr size_t MiB = (size_t)1 << 20;
constexpr size_t WS_CTL = 0;
constexpr size_t WS_WIN = 1 * MiB;
constexpr size_t WS_WUQ = 11 * MiB;
constexpr size_t WS_WUKV = 13 * MiB;
constexpr size_t WS_WBA = 14 * MiB, WS_WBB = 15 * MiB;
constexpr size_t WS_WOUT = 16 * MiB;
constexpr size_t WS_ROPE = 954 * MiB;
constexpr size_t WS_XN8 = 960 * MiB;
constexpr int FP8_PN0 = 11, FP8_C0 = FP8_PN0 * 256;
constexpr size_t WS_WIN8 = 1 * MiB + (size_t)FP8_C0 * 2048;
constexpr size_t WS_WRH = 958 * MiB, WS_WRL = 958 * MiB + 65536;
constexpr size_t WS_TOPI = 19 * MiB;
constexpr size_t WS_TOPW = 20 * MiB;
constexpr size_t WS_SLOT = 21 * MiB;
constexpr size_t WS_TOKOF = 22 * MiB;
constexpr size_t WS_WOF = 23 * MiB;
constexpr size_t WS_RSOF = 25 * MiB;
constexpr size_t WS_HB = 762 * MiB;
constexpr size_t WS_SSP = 19 * MiB;
constexpr size_t WS_MISC = 24 * MiB;
constexpr size_t WS_LOGIT = 400 * MiB;
constexpr size_t WS_PROJ = 26 * MiB;
constexpr size_t WS_XN = 634 * MiB;
constexpr size_t WS_QA = 634 * MiB;
constexpr size_t WS_KV = 730 * MiB;
constexpr size_t WS_OA = 890 * MiB;
constexpr size_t WS_OD = 634 * MiB;
constexpr size_t WS_OB = 960 * MiB;
constexpr size_t WS_MERGED = 634 * MiB;
constexpr size_t WS_W1 = 26 * MiB;
constexpr size_t WS_W2 = 154 * MiB;
constexpr size_t WS_T = 186 * MiB;
constexpr size_t WS_ACT = 250 * MiB;
constexpr size_t WS_Y = 506 * MiB;
constexpr size_t WS_END = 1024 * MiB;
constexpr size_t MS_CHUNKCNT = 0;
constexpr size_t MS_CHUNKBASE = 64 * 1024;
constexpr size_t MS_EBASE = 128 * 1024;
constexpr size_t MS_NTILES = 132 * 1024;
constexpr size_t MS_TILES = 136 * 1024;
constexpr size_t MS_LAMBDA = 256 * 1024;
constexpr size_t MS_RSTD = 512 * 1024;
constexpr size_t MS_RQ = 768 * 1024;
constexpr size_t MS_SBOUND = 260 * 1024;
constexpr int CW_BAR = 4096;

struct Params {
    const float* x; const float* attn_norm; const float* w_in; const float* q_lat_norm; const float* kv_lat_norm; const float* w_uq; const float* w_ukv;
    const float* mla_q_norm; const float* mla_k_norm; const float* diff_q_norm; const float* diff_k_norm; const float* lq1; const float* lk1; const float* lq2; const float* lk2;
    const float* subln; const float* w_ba; const float* w_bb; const float* w_out; const float* ffn_norm; const float* w_router; const float* b_router;
    const float* w1; const float* b1; const float* w2; const float* b2;
    float* out; unsigned char* ws;
    int ph_lo, ph_hi;
};
template <class T> HD T* wsp(const Params& p, size_t off) { return (T*)(p.ws + off); }

HD void wt_item(const float* src, int N, bf16_t* dst, int K, int n_dst, int n_src, int k0, const float* gain) {
    float v[8];
#pragma unroll
    for (int j = 0; j < 8; ++j) { float s = (n_src >= 0) ? src[(size_t)(k0 + j) * N + n_src] : 0.f; if (gain) s *= gain[k0 + j]; v[j] = s; }
    store8(dst + (size_t)n_dst * K + k0, v);
}
HD void wt_item8(const float* src, int N, unsigned char* dst, int K, int n_dst, int n_src, int k0, float mul) {
    float v[8];
#pragma unroll
    for (int j = 0; j < 8; ++j) v[j] = src[(size_t)(k0 + j) * N + n_src];
    store8_e4m3(dst + (size_t)n_dst * K + k0, v, mul);
}
HD int win_src_col(int pc) { return pc < 1056 ? pc : (pc < 1280 ? -1 : pc - 224); }
HD int wukv_src_col(int c) { const int h = c / 160, j = c % 160; return j < 64 ? h * 128 + j : (j < 96 ? -1 : h * 128 + 64 + (j - 96)); }
HD int w1_src_col(int n) { const int pn = n >> 8, j = n & 255; return j < 128 ? pn * 128 + j : 1024 + pn * 128 + (j - 128); }

constexpr int IT_WIN = PROJ_W * (1024 / 8), IT_WUQ = 768 * (768 / 8), IT_WUKV = 1024 * (256 / 8), IT_WB = 1024 * (512 / 8), IT_WOUT = 1024 * (1024 / 8);
constexpr int IT_SMALLW = IT_WIN + IT_WUQ + IT_WUKV + 2 * IT_WB + IT_WOUT;
HD void smallw_item(const Params& p, int it) {
#if FP8_INPROJ
    if (it < IT_WIN) { const int kc = it / PROJ_W, n = it % PROJ_W; const int sc = win_src_col(n); if (sc >= 0) wt_item8(p.w_in, 4640, wsp<unsigned char>(p, WS_WIN), 1024, n, sc, kc * 8, (float)(1 << EXP_W)); else { float z[8] = {0, 0, 0, 0, 0, 0, 0, 0}; store8_e4m3(wsp<unsigned char>(p, WS_WIN) + (size_t)n * 1024 + kc * 8, z, 1.f); } return; } it -= IT_WIN;
#else
    if (it < IT_WIN) { const int kc = it / PROJ_W, n = it % PROJ_W;
        if (FP8_GATES && n >= FP8_C0) wt_item8(p.w_in, 4640, wsp<unsigned char>(p, WS_WIN8), 1024, n - FP8_C0, win_src_col(n), kc * 8, (float)(1 << EXP_W));
        else wt_item(p.w_in, 4640, wsp<bf16_t>(p, WS_WIN), 1024, n, win_src_col(n), kc * 8, nullptr); return; } it -= IT_WIN;
#endif
    if (it < IT_WUQ) { const int kc = it / 768, n = it % 768; wt_item(p.w_uq, 768, wsp<bf16_t>(p, WS_WUQ), 768, n, n, kc * 8, p.q_lat_norm); return; } it -= IT_WUQ;
    if (it < IT_WUKV) { const int kc = it / 1024, n = it % 1024; wt_item(p.w_ukv, 1024, wsp<bf16_t>(p, WS_WUKV), 256, n, n, kc * 8, p.kv_lat_norm); return; } it -= IT_WUKV;
    if (it < IT_WB) { const int kc = it / 1024, n = it % 1024; wt_item(p.w_ba, 1024, wsp<bf16_t>(p, WS_WBA), 512, n, n, kc * 8, nullptr); return; } it -= IT_WB;
    if (it < IT_WB) { const int kc = it / 1024, n = it % 1024; wt_item(p.w_bb, 1024, wsp<bf16_t>(p, WS_WBB), 512, n, n, kc * 8, nullptr); return; } it -= IT_WB;
    { const int kc = it / 1024, n = it % 1024; wt_item(p.w_out, 1024, wsp<bf16_t>(p, WS_WOUT), 1024, n, n, kc * 8, nullptr); }
}
constexpr long IT_W1 = (long)NE * 2048 * 128, IT_W2 = (long)NE * 1024 * 128, IT_MOEW = IT_W1 + IT_W2;
HD void moew_item(const Params& p, long it) {
    if (it < IT_W1) { const int e = (int)(it / (2048 * 128)), r = (int)(it % (2048 * 128)), kc = r / 2048, n = r % 2048;
        wt_item8(p.w1 + (size_t)e * 1024 * 2048, 2048, wsp<unsigned char>(p, WS_W1) + (size_t)e * 2048 * 1024, 1024, n, w1_src_col(n), kc * 8, (float)(1 << EXP_W)); return; }
    it -= IT_W1;
    { const int e = (int)(it / (1024 * 128)), r = (int)(it % (1024 * 128)), kc = r / 1024, n = r % 1024;
        wt_item8(p.w2 + (size_t)e * 1024 * 1024, 1024, wsp<unsigned char>(p, WS_W2) + (size_t)e * 1024 * 1024, 1024, n, n, kc * 8, (float)(1 << EXP_W)); }
}

HD void rope_item(float* tab, int nf, int dim, int pos, int i) {
    const float inv = 1.0f / powf(10000.0f, (float)(2 * i) / (float)dim);
    const float ang = (float)pos * inv;
    const double a = (double)ang; const double n = rint(a * 0.63661977236758134308); const double r = a - n * 1.57079632679489661923;
    const double r2 = r * r;
    const double s = r * (1.0 + r2 * (-1.0 / 6 + r2 * (1.0 / 120 + r2 * (-1.0 / 5040 + r2 * (1.0 / 362880 - r2 * (1.0 / 39916800))))));
    const double c = 1.0 + r2 * (-0.5 + r2 * (1.0 / 24 + r2 * (-1.0 / 720 + r2 * (1.0 / 40320 + r2 * (-1.0 / 3628800 + r2 * (1.0 / 479001600))))));
    const int q = ((int)n) & 3; double cs, sn;
    if (q == 0) { cs = c; sn = s; } else if (q == 1) { cs = -s; sn = c; } else if (q == 2) { cs = -c; sn = -s; } else { cs = s; sn = -c; }
    tab[((size_t)pos * nf + i) * 2 + 0] = (float)cs; tab[((size_t)pos * nf + i) * 2 + 1] = (float)sn;
}
constexpr int IT_ROPE = SEQ * 48;
HD void rope_tab_item(const Params& p, int it) {
    float* tab = wsp<float>(p, WS_ROPE);
    const int pos = it / 48, i = it % 48;
    if (i < 16) rope_item(tab, 16, 32, pos, i); else rope_item(tab + (size_t)SEQ * 16 * 2, 32, 64, pos, i - 16);
}
HD void sbound_item(const Params& p) {
    float gq = 0.f, gk = 0.f, dq = 0.f, dk = 0.f;
    for (int i = 0; i < 96; ++i) { gq = fmaxf(gq, fabsf(p.mla_q_norm[i])); gk = fmaxf(gk, fabsf(p.mla_k_norm[i])); }
    for (int i = 0; i < 64; ++i) { dq = fmaxf(dq, fabsf(p.diff_q_norm[i])); dk = fmaxf(dk, fabsf(p.diff_k_norm[i])); }
    float* sb = wsp<float>(p, WS_MISC + MS_SBOUND);
    sb[0] = 1.01f * 96.f * QSCALE_MLA * gq * gk; sb[1] = 1.01f * 64.f * QSCALE_DIFF * dq * dk;
}
HD void lambda_item(const Params& p) {
    float a = 0.f, b = 0.f;
    for (int i = 0; i < 64; ++i) { a += p.lq1[i] * p.lk1[i]; b += p.lq2[i] * p.lk2[i]; }
    *wsp<float>(p, WS_MISC + MS_LAMBDA) = expf(a) - expf(b) + LAMBDA_INIT;
}

HD void xn_row_scalar(const Params& p, int token) {
    const float* xr = p.x + (size_t)token * 1024; float ss = 0.f;
    for (int c = 0; c < 1024; ++c) ss += xr[c] * xr[c];
    const float rs = 1.0f / sqrtf(ss * (1.0f / 1024) + EPS);
#if FP8_INPROJ
    unsigned char* o = wsp<unsigned char>(p, WS_XN) + (size_t)token * 1024;
    for (int c = 0; c < 1024; c += 8) { float v[8]; for (int j = 0; j < 8; ++j) v[j] = xr[c + j] * rs * p.attn_norm[c + j]; store8_e4m3(o + c, v, (float)(1 << EXP_T)); }
#else
    bf16_t* o = wsp<bf16_t>(p, WS_XN) + (size_t)token * 1024;
    for (int c = 0; c < 1024; ++c) o[c] = f2bf(xr[c] * rs * p.attn_norm[c]);
#endif
#if FP8_GATES
    { unsigned char* o8 = wsp<unsigned char>(p, WS_XN8) + (size_t)token * 1024;
      for (int c = 0; c < 1024; c += 8) { float v[8]; for (int j = 0; j < 8; ++j) v[j] = xr[c + j] * rs * p.attn_norm[c + j]; store8_e4m3(o8 + c, v, (float)(1 << EXP_T)); } }
#endif
}

template <int HDIM, int NF, class SRC> HD void norm_rope_stream(const SRC& src, bf16_t* dst, const float* gain, const float* tab, float oscale) {
    float ss = 0.f;
#pragma unroll 2
    for (int c = 0; c < HDIM / 8; ++c) { float v[8]; src.load(c, v);
#pragma unroll
        for (int j = 0; j < 8; ++j) ss += v[j] * v[j]; }
    const float rs = oscale / sqrtf(ss * (1.0f / HDIM) + EPS);
    constexpr int R0 = (HDIM - 2 * NF) / 8, NC = NF / 8;
#pragma unroll 2
    for (int c = 0; c < R0; ++c) { float v[8]; src.load(c, v);
#pragma unroll
        for (int j = 0; j < 8; ++j) v[j] = v[j] * rs * gain[c * 8 + j];
        store8(dst + c * 8, v); }
#pragma unroll 1
    for (int i = 0; i < NC; ++i) { float a[8], b[8]; src.load(R0 + i, a); src.load(R0 + NC + i, b);
#pragma unroll
        for (int j = 0; j < 8; ++j) { const float x1 = a[j] * rs * gain[(R0 + i) * 8 + j], x2 = b[j] * rs * gain[(R0 + NC + i) * 8 + j]; const float cs = tab[2 * (i * 8 + j)], sn = tab[2 * (i * 8 + j) + 1];
            a[j] = x1 * cs - x2 * sn; b[j] = x2 * cs + x1 * sn; }
        store8(dst + (R0 + i) * 8, a); store8(dst + (R0 + NC + i) * 8, b); }
}
HD float row_rstd_bf16(const bf16_t* row, int n) {
    float ss = 0.f;
#pragma unroll 4
    for (int c = 0; c < n; c += 8) { float v[8]; load8(row + c, v);
#pragma unroll
        for (int j = 0; j < 8; ++j) ss += v[j] * v[j]; }
    return 1.0f / sqrtf(ss / (float)n + EPS);
}
struct SrcScaled { const bf16_t* p; float s; HD void load(int c, float* v) const { load8(p + c * 8, v);
#pragma unroll
    for (int j = 0; j < 8; ++j) v[j] *= s; } };
struct SrcK { const bf16_t* kv; const bf16_t* kpe; float s; HD void load(int c, float* v) const { if (c < 8) { load8(kv + c * 8, v);
#pragma unroll
    for (int j = 0; j < 8; ++j) v[j] *= s; } else load8(kpe + (c - 8) * 8, v); } };
HD void post_item(const Params& p, long item, float rq, float rkv) {
    const int token = (int)(item >> 5), s = (int)(item & 31), pos = token % SEQ;
    const bf16_t* proj = wsp<bf16_t>(p, WS_PROJ) + (size_t)token * PROJ_W;
    const float* tab_mla = wsp<float>(p, WS_ROPE) + (size_t)pos * 16 * 2;
    const float* tab_diff = wsp<float>(p, WS_ROPE) + (size_t)SEQ * 16 * 2 + (size_t)pos * 32 * 2;
    if (s < 8) {
        bf16_t* q = wsp<bf16_t>(p, WS_QA) + (size_t)token * QA_W + s * 96;
        norm_rope_stream<96, 16>(SrcScaled{q, rq}, q, p.mla_q_norm, tab_mla, QSCALE_MLA);
    } else if (s < 16) {
        const int h = s - 8;
        bf16_t* kv = wsp<bf16_t>(p, WS_KV) + (size_t)token * KV_W + h * 160;
        norm_rope_stream<96, 16>(SrcK{kv, proj + PC_KPE, rkv}, kv, p.mla_k_norm, tab_mla, 1.0f);
#pragma unroll 2
        for (int c = 0; c < 64; c += 8) { float v[8]; load8(kv + 96 + c, v);
#pragma unroll
            for (int j = 0; j < 8; ++j) v[j] *= rkv;
            store8(kv + 96 + c, v); }
    } else {
        const int sub = (s - 16) & 7; const bool isk = s >= 24;
        bf16_t* q = wsp<bf16_t>(p, WS_PROJ) + (size_t)token * PROJ_W + (isk ? PC_DK : PC_DQ) + sub * 64;
        norm_rope_stream<64, 32>(SrcScaled{q, 1.0f}, q, isk ? p.diff_k_norm : p.diff_q_norm, tab_diff, isk ? 1.0f : QSCALE_DIFF);
    }
}

HD void combine_item(const Params& p, long item) {
    const int token = (int)(item >> 2), h = (int)(item & 3);
    const float lam = *wsp<float>(p, WS_MISC + MS_LAMBDA);
    const bf16_t* od = wsp<bf16_t>(p, WS_OD) + (size_t)token * OD_W + h * 256;
    float ss = 0.f;
#pragma unroll 2
    for (int c = 0; c < 128; c += 8) { float a[8], b[8]; load8(od + c, a); load8(od + 128 + c, b);
#pragma unroll
        for (int j = 0; j < 8; ++j) { const float v = a[j] - lam * b[j]; ss += v * v; } }
    const float rs = 1.0f / sqrtf(ss * (1.0f / 128) + EPS);
    bf16_t* ob = wsp<bf16_t>(p, WS_OB) + (size_t)token * 512 + h * 128;
#pragma unroll 2
    for (int c = 0; c < 128; c += 8) { float a[8], b[8], o[8]; load8(od + c, a); load8(od + 128 + c, b);
#pragma unroll
        for (int j = 0; j < 8; ++j) o[j] = (a[j] - lam * b[j]) * rs * p.subln[c + j] * (1.0f - LAMBDA_INIT);
        store8(ob + c, o); }
}

HD void wr_frag_item(const Params& p, int item) {
    const int s = item >> 6, l = item & 63, e = l & 31, kb = 16 * s + 8 * (l >> 5);
    float hi[8], lo[8];
#pragma unroll
    for (int j = 0; j < 8; ++j) { const float v = p.ffn_norm[kb + j] * p.w_router[(size_t)(kb + j) * NE + e]; const float h = bf2f(f2bf(v)); hi[j] = h; lo[j] = v - h; }
    store8(wsp<bf16_t>(p, WS_WRH) + (size_t)item * 8, hi); store8(wsp<bf16_t>(p, WS_WRL) + (size_t)item * 8, lo);
}
HD void ffn_rstd_scalar(const Params& p, int token) {
    const float* hr = p.out + (size_t)token * 1024; float ss = 0.f;
    for (int c = 0; c < 1024; ++c) ss += hr[c] * hr[c];
    wsp<float>(p, WS_MISC + MS_RSTD)[token] = 1.0f / sqrtf(ss * (1.0f / 1024) + EPS);
}
HD void t_item(const Params& p, long item) {
    const int token = (int)(item >> 7), c0 = (int)(item & 127) * 8;
    const float rs = wsp<float>(p, WS_MISC + MS_RSTD)[token];
    const float* hr = p.out + (size_t)token * 1024 + c0; float v[8];
#pragma unroll
    for (int j = 0; j < 8; ++j) v[j] = hr[j] * rs * p.ffn_norm[c0 + j];
    store8_e4m3(wsp<unsigned char>(p, WS_T) + (size_t)token * 1024 + c0, v, (float)(1 << EXP_T));
}
HD void logit_item(const Params& p, long item) {
    const int token = (int)(item >> 5), e = (int)(item & 31);
    const float rs = wsp<float>(p, WS_MISC + MS_RSTD)[token];
    const float* hr = p.out + (size_t)token * 1024; float acc = 0.f;
    for (int c = 0; c < 1024; ++c) acc += (hr[c] * rs * p.ffn_norm[c]) * p.w_router[c * NE + e];
    wsp<float>(p, WS_LOGIT)[(size_t)token * NE + e] = acc + p.b_router[e];
}
HD void top4_item(const Params& p, int token) {
    const float* lg = wsp<float>(p, WS_LOGIT) + (size_t)token * NE;
    float v[NE];
#pragma unroll
    for (int e = 0; e < NE; ++e) v[e] = lg[e];
    int idx[4]; float val[4];
#pragma unroll
    for (int k = 0; k < 4; ++k) { int bi = 0; float bv = -INFINITY;
#pragma unroll
        for (int e = 0; e < NE; ++e) { const bool taken = (k > 0 && idx[0] == e) || (k > 1 && idx[1] == e) || (k > 2 && idx[2] == e); if (!taken && v[e] > bv) { bv = v[e]; bi = e; } }
        idx[k] = bi; val[k] = bv; }
    const float m = val[0]; float ex[4], sum = 0.f;
#pragma unroll
    for (int k = 0; k < 4; ++k) { ex[k] = expf(val[k] - m); sum += ex[k]; }
    int* ti = wsp<int>(p, WS_TOPI) + (size_t)token * 4; float* tw = wsp<float>(p, WS_TOPW) + (size_t)token * 4;
#pragma unroll
    for (int k = 0; k < 4; ++k) { ti[k] = idx[k]; tw[k] = ex[k] / sum; }
}
HD void chunkcnt_item(const Params& p, int item) {
    const int chunk = item >> 5, e = item & 31; const int* ti = wsp<int>(p, WS_TOPI) + (size_t)chunk * CHUNK * 4; int c = 0;
    for (int i = 0; i < CHUNK * 4; ++i) c += (ti[i] == e) ? 1 : 0;
    wsp<int>(p, WS_MISC + MS_CHUNKCNT)[item] = c;
}
HD void route_expert_item(const Params& p, int e) {
    const int* cc = wsp<int>(p, WS_MISC + MS_CHUNKCNT); int* cb = wsp<int>(p, WS_MISC + MS_CHUNKBASE); int* eb = wsp<int>(p, WS_MISC + MS_EBASE);
    for (int hf = 0; hf < NHALF; ++hf) { int run = 0;
        for (int ch = hf * CHUNK_PER_HALF; ch < (hf + 1) * CHUNK_PER_HALF; ++ch) { cb[ch * 32 + e] = run; run += cc[ch * 32 + e]; }
        eb[hf * 33 + e] = run; }
}
HD void route_final_item(const Params& p) {
    int* eb = wsp<int>(p, WS_MISC + MS_EBASE); int* nt = wsp<int>(p, WS_MISC + MS_NTILES); int* tl = wsp<int>(p, WS_MISC + MS_TILES);
    for (int hf = 0; hf < NHALF; ++hf) { int run = 0, n = 0;
        for (int e = 0; e < NE; ++e) { const int cnt = eb[hf * 33 + e]; eb[hf * 33 + e] = run;
            for (int r = 0; r < cnt; r += 256) { int* t = tl + ((size_t)hf * MAX_TILES + n) * 4; t[0] = e; t[1] = run + r; t[2] = (cnt - r) < 256 ? (cnt - r) : 256; t[3] = 0; ++n; }
            run += cnt; }
        eb[hf * 33 + NE] = run; nt[hf] = n; }
}
HD void slot_item(const Params& p, long item, int base) {
    const int token = (int)(item >> 2), chunk = token / CHUNK, hf = chunk / CHUNK_PER_HALF;
    const int* ti = wsp<int>(p, WS_TOPI); const int e = ti[item];
    int rank = 0;
    for (int t = chunk * CHUNK; t < token; ++t) { const int* q = ti + (size_t)t * 4; rank += (q[0] == e) + (q[1] == e) + (q[2] == e) + (q[3] == e); }
    const int slot = base + rank;
    wsp<int>(p, WS_SLOT)[item] = slot;
    wsp<int>(p, WS_TOKOF)[(size_t)hf * HALF_SLOTS + slot] = token;
    wsp<float>(p, WS_WOF)[(size_t)hf * HALF_SLOTS + slot] = wsp<float>(p, WS_TOPW)[item];
}
HD int slot_base_global(const Params& p, long item) { const int token = (int)(item >> 2), chunk = token / CHUNK, hf = chunk / CHUNK_PER_HALF; const int e = wsp<int>(p, WS_TOPI)[item];
    return wsp<int>(p, WS_MISC + MS_EBASE)[hf * 33 + e] + wsp<int>(p, WS_MISC + MS_CHUNKBASE)[chunk * 32 + e]; }
HD void final_item(const Params& p, int hf, long item) {
    const int token = hf * HALF_TOK + (int)(item >> 7), c0 = (int)(item & 127) * 8;
    const int* sl = wsp<int>(p, WS_SLOT) + (size_t)token * 4; const unsigned char* Y = wsp<unsigned char>(p, WS_Y);
    float* o = p.out + (size_t)token * 1024 + c0; float acc[8];
    load8(wsp<bf16_t>(p, WS_HB) + (size_t)token * 1024 + c0, acc);
#pragma unroll
    for (int k = 0; k < 4; ++k) { float y[8]; load8_e4m3(Y + (size_t)sl[k] * 1024 + c0, y, 1.0f / (float)(1 << EXP_Y));
#pragma unroll
        for (int j = 0; j < 8; ++j) acc[j] += y[j]; }
#if defined(__HIP_DEVICE_COMPILE__)
    __builtin_nontemporal_store((f32x4){acc[0], acc[1], acc[2], acc[3]}, (f32x4*)o); __builtin_nontemporal_store((f32x4){acc[4], acc[5], acc[6], acc[7]}, (f32x4*)(o + 4));
#else
    for (int j = 0; j < 8; ++j) o[j] = acc[j];
#endif
}

struct Unit { int row0, pn, nrows, aux; };
typedef f32x4 Acc[2][2][4][2];
HD void acc8(const Acc& acc, int ai, int bj, int m, float* v) {
    const f32x4 a = acc[ai][bj][m][0], b = acc[ai][bj][m][1];
    v[0] = a[0]; v[1] = a[1]; v[2] = a[2]; v[3] = a[3]; v[4] = b[0]; v[5] = b[1]; v[6] = b[2]; v[7] = b[3];
}
struct GridPos { int G, c; };
HD bool static_order(const GridPos& g, long L, int nM, int nN, int& pm, int& pn) {
    const long nwg = (long)nM * nN; if (L >= nwg) return false;
    long wgid = L; { const long q = nwg / 8, r = nwg % 8, xcd = wgid % 8, off = wgid / 8; wgid = (xcd < r ? xcd * (q + 1) : r * (q + 1) + (xcd - r) * q) + off; }
    const int WGM = 8; const long nig = (long)WGM * nN; const int gid = (int)(wgid / nig), fm = gid * WGM, gsz = (nM - fm) < WGM ? (nM - fm) : WGM;
    pm = fm + (int)((wgid % nig) % gsz); pn = (int)((wgid % nig) / gsz); return true;
}
#if defined(__HIP_DEVICE_COMPILE__)
#define HD_SCHED_BARRIER() __builtin_amdgcn_sched_barrier(0)
#else
#define HD_SCHED_BARRIER() do { } while (0)
#endif
#define FOR_AI_M _Pragma("unroll") for (int ai = 0; ai < 2; ++ai) _Pragma("unroll") for (int m = 0; m < 4; ++m)
#define FOR_BJ _Pragma("unroll") for (int bj = 0; bj < 2; ++bj)
#define FOR_J8 _Pragma("unroll") for (int j = 0; j < 8; ++j)

constexpr bool GATES_U8 = FP8_GATES && (FP8_PN0 * 256 == PC_GA);
struct ProbInProj {
    static constexpr bool HAS_MID = false;
#if FP8_INPROJ
    static constexpr int ESZ = 1, EXA = EXP_T, EXB = EXP_W; typedef unsigned char el_t;
#else
    static constexpr int ESZ = 2, EXA = 0, EXB = 0; typedef bf16_t el_t;
#endif
    GridPos g; const el_t* A_; const el_t* Bt; bf16_t* P; float* ssp;
    HD int K() const { return 1024; }
    HD const el_t* A() const { return A_; }
    HD size_t arow(const Unit& u, int r) const { return (size_t)(u.row0 + r) * 1024; }
    HD const el_t* B(const Unit& u) const { return Bt + (size_t)u.pn * 256 * 1024; }
    HD bool next(int i, Unit& u) const { int pm, pn; if (!static_order(g, (long)i * g.G + g.c, NTOK / 256, FP8_GATES ? FP8_PN0 : 19, pm, pn)) return false; u.row0 = pm * 256; u.pn = pn; u.nrows = 256; u.aux = 0; return true; }
    HD void epi(const Acc& acc, const Unit& u, int wr, int wc, int fr, int fq) const {
        const bool gate = u.pn * 256 >= PC_GA;
        FOR_AI_M { const int tr = 128 * ai + 64 * wr + 16 * m + fr; float ssq = 0.f;
            FOR_BJ { float v[8]; acc8(acc, ai, bj, m, v);
                if (gate) { FOR_J8 v[j] = sigmoidf_(v[j]); }
                FOR_J8 ssq += v[j] * v[j];
                store8(P + (size_t)(u.row0 + tr) * PROJ_W + u.pn * 256 + 128 * bj + 32 * wc + 8 * fq, v); }
#if defined(__HIP_DEVICE_COMPILE__)
            if (u.pn < 4) { ssq += __shfl_xor(ssq, 16); ssq += __shfl_xor(ssq, 32);
                if (fq == 0) ssp[(size_t)(u.row0 + tr) * 16 + u.pn * 4 + wc] = ssq; }
#endif
        }
    }
};
struct ProbInProjG {
    static constexpr bool HAS_MID = false;
    static constexpr int ESZ = 1, EXA = EXP_T, EXB = EXP_W;
    GridPos g; const unsigned char* A_; const unsigned char* Bt; bf16_t* P;
    HD int K() const { return 1024; }
    HD const unsigned char* A() const { return A_; }
    HD size_t arow(const Unit& u, int r) const { return (size_t)(u.row0 + r) * 1024; }
    HD const unsigned char* B(const Unit& u) const { return Bt + (size_t)(u.pn - FP8_PN0) * 256 * 1024; }
    HD bool next(int i, Unit& u) const { int pm, pn; if (!static_order(g, (long)i * g.G + g.c, NTOK / 256, 19 - FP8_PN0, pm, pn)) return false; u.row0 = pm * 256; u.pn = FP8_PN0 + pn; u.nrows = 256; u.aux = 0; return true; }
    HD void epi(const Acc& acc, const Unit& u, int wr, int wc, int fr, int fq) const {
#if defined(__HIP_DEVICE_COMPILE__)
        if (GATES_U8) {
            _Pragma("unroll") for (int ai = 0; ai < 2; ++ai) _Pragma("unroll") for (int mp = 0; mp < 4; mp += 2) { unsigned px[2][2], py[2][2];
                _Pragma("unroll") for (int d = 0; d < 2; ++d) FOR_BJ { float v[8]; acc8(acc, ai, bj, mp + d, v); FOR_J8 v[j] = sigmoidf_(v[j]); pack8_gate(v, px[bj][d], py[bj][d]); }
                const int tr = 128 * ai + 64 * wr + 16 * (mp + (fq & 1)) + fr; unsigned char* g8 = (unsigned char*)(P + (size_t)(u.row0 + tr) * PROJ_W + PC_GA) + (u.pn * 256 - PC_GA);
                FOR_BJ { const auto sx = __builtin_amdgcn_permlane16_swap(px[bj][0], px[bj][1], false, false); const auto sy = __builtin_amdgcn_permlane16_swap(py[bj][0], py[bj][1], false, false);
                    *(u32x4*)(g8 + 128 * bj + 32 * wc + 8 * (fq & ~1)) = (u32x4){sx[0], sy[0], sx[1], sy[1]}; } }
            return; }
#endif
        FOR_AI_M { const int tr = 128 * ai + 64 * wr + 16 * m + fr;
            FOR_BJ { float v[8]; acc8(acc, ai, bj, m, v); if (u.pn * 256 >= PC_GA) { FOR_J8 v[j] = sigmoidf_(v[j]); }
                if (GATES_U8) store8_gate((unsigned char*)(P + (size_t)(u.row0 + tr) * PROJ_W + PC_GA) + (u.pn * 256 - PC_GA) + 128 * bj + 32 * wc + 8 * fq, v);
                else store8(P + (size_t)(u.row0 + tr) * PROJ_W + u.pn * 256 + 128 * bj + 32 * wc + 8 * fq, v); } }
    }
};
struct ProbUpQ {
    static constexpr bool HAS_MID = false;
    static constexpr int ESZ = 2, EXA = 0, EXB = 0;
    GridPos g; const bf16_t* proj; const bf16_t* wt; bf16_t* O;
    HD int K() const { return 768; }
    HD const bf16_t* A() const { return proj + PC_QLAT; }
    HD size_t arow(const Unit& u, int r) const { return (size_t)(u.row0 + r) * PROJ_W; }
    HD const bf16_t* B(const Unit& u) const { return wt + (size_t)u.pn * 256 * 768; }
    HD bool next(int i, Unit& u) const { int pm, pn; if (!static_order(g, (long)i * g.G + g.c, NTOK / 256, 3, pm, pn)) return false; u.row0 = pm * 256; u.pn = pn; u.nrows = 256; u.aux = 0; return true; }
    HD void epi(const Acc& acc, const Unit& u, int wr, int wc, int fr, int fq) const {
        FOR_AI_M { const int tr = 128 * ai + 64 * wr + 16 * m + fr;
            FOR_BJ { float v[8]; acc8(acc, ai, bj, m, v); store8(O + (size_t)(u.row0 + tr) * QA_W + u.pn * 256 + 128 * bj + 32 * wc + 8 * fq, v); } }
    }
};
struct ProbUpKV {
    static constexpr bool HAS_MID = false;
    static constexpr int ESZ = 2, EXA = 0, EXB = 0;
    GridPos g; const bf16_t* proj; const bf16_t* wt; bf16_t* O; const float* ssp;
    HD int K() const { return 256; }
    HD const bf16_t* A() const { return proj + PC_KVLAT; }
    HD size_t arow(const Unit& u, int r) const { return (size_t)(u.row0 + r) * PROJ_W; }
    HD const bf16_t* B(const Unit& u) const { return wt + (size_t)u.pn * 256 * 256; }
    HD bool next(int i, Unit& u) const { int pm, pn; if (!static_order(g, (long)i * g.G + g.c, NTOK / 256, 4, pm, pn)) return false; u.row0 = pm * 256; u.pn = pn; u.nrows = 256; u.aux = 0; return true; }
    HD void epi(const Acc& acc, const Unit& u, int wr, int wc, int fr, int fq) const {
        float rkv[2][4];
        FOR_AI_M { const f32x4 q = *(const f32x4*)(ssp + (size_t)(u.row0 + 128 * ai + 64 * wr + 16 * m + fr) * 16 + 12); rkv[ai][m] = 1.0f / sqrtf((q[0] + q[1] + q[2] + q[3]) * (1.0f / KVLORA) + EPS); }
        HD_SCHED_BARRIER();
        FOR_AI_M { const int tr = 128 * ai + 64 * wr + 16 * m + fr;
            FOR_BJ { float v[8]; acc8(acc, ai, bj, m, v); FOR_J8 v[j] *= rkv[ai][m];
                const int n = u.pn * 256 + 128 * bj + 32 * wc + 8 * fq, hh = n >> 7, j = n & 127; store8(O + (size_t)(u.row0 + tr) * KV_W + hh * 160 + (j < 64 ? j : j + 32), v); } }
    }
};
struct ProbBranch {
    static constexpr bool HAS_MID = true;
    static constexpr int ESZ = 2, EXA = 0, EXB = 0;
    GridPos g; const bf16_t* base; size_t offA, offB; const bf16_t* wa; const bf16_t* wb; const bf16_t* proj; bf16_t* M;
    HD int K() const { return 512; }
    HD const bf16_t* A() const { return base; }
    HD size_t arow(const Unit& u, int r) const { return (u.aux ? offB : offA) + (size_t)(u.row0 + r) * 512; }
    HD const bf16_t* B(const Unit& u) const { return (u.aux ? wb : wa) + (size_t)u.pn * 256 * 512; }
    HD bool next(int i, Unit& u) const { int pm, pn; if (!static_order(g, (long)(i >> 1) * g.G + g.c, NTOK / 256, 4, pm, pn)) return false; u.row0 = pm * 256; u.pn = pn; u.nrows = 256; u.aux = i & 1; return true; }
    HD bool is_mid(const Unit& u) const { return u.aux == 0; }
    HD void epi_mid(Acc& acc, const Unit& u, int wr, int wc, int fr, int fq) const {
        FOR_AI_M { const int tr = 128 * ai + 64 * wr + 16 * m + fr;
            FOR_BJ { const int col = u.pn * 256 + 128 * bj + 32 * wc + 8 * fq; float ga[8], gb[8];
                if (GATES_U8) { const unsigned char* g8 = (const unsigned char*)(proj + (size_t)(u.row0 + tr) * PROJ_W + PC_GA); load8_gate(g8 + col, ga); load8_gate(g8 + (PC_GB - PC_GA) + col, gb); }
                else { load8(proj + (size_t)(u.row0 + tr) * PROJ_W + PC_GA + col, ga); load8(proj + (size_t)(u.row0 + tr) * PROJ_W + PC_GB + col, gb); }
                FOR_J8 { const float r = ga[j] / fmaxf(gb[j], 1e-30f); if (j < 4) acc[ai][bj][m][0][j] *= r; else acc[ai][bj][m][1][j - 4] *= r; } } }
    }
    HD void epi(const Acc& acc, const Unit& u, int wr, int wc, int fr, int fq) const {
        FOR_AI_M { const int tr = 128 * ai + 64 * wr + 16 * m + fr;
            FOR_BJ { const int col = u.pn * 256 + 128 * bj + 32 * wc + 8 * fq; float v[8], gb[8]; acc8(acc, ai, bj, m, v);
                if (GATES_U8) load8_gate((const unsigned char*)(proj + (size_t)(u.row0 + tr) * PROJ_W + PC_GA) + (PC_GB - PC_GA) + col, gb);
                else load8(proj + (size_t)(u.row0 + tr) * PROJ_W + PC_GB + col, gb);
                FOR_J8 v[j] *= fmaxf(gb[j], 1e-30f);
                store8(M + (size_t)(u.row0 + tr) * 1024 + col, v); } }
    }
};
struct ProbOut {
    static constexpr bool HAS_MID = false;
    static constexpr int ESZ = 2, EXA = 0, EXB = 0;
    GridPos g; const bf16_t* M; const bf16_t* wt; const float* x; bf16_t* hb;
    HD int K() const { return 1024; }
    HD const bf16_t* A() const { return M; }
    HD size_t arow(const Unit& u, int r) const { return (size_t)(u.row0 + r) * 1024; }
    HD const bf16_t* B(const Unit& u) const { return wt + (size_t)u.pn * 256 * 1024; }
    HD bool next(int i, Unit& u) const { int pm, pn; if (!static_order(g, (long)i * g.G + g.c, NTOK / 256, 4, pm, pn)) return false; u.row0 = pm * 256; u.pn = pn; u.nrows = 256; u.aux = 0; return true; }
    HD void epi(const Acc& acc, const Unit& u, int wr, int wc, int fr, int fq) const {
        FOR_AI_M { const int tr = 128 * ai + 64 * wr + 16 * m + fr;
            FOR_BJ { const size_t off = (size_t)(u.row0 + tr) * 1024 + u.pn * 256 + 128 * bj + 32 * wc + 8 * fq;
                const f32x4 x0 = *(const f32x4*)(x + off) + acc[ai][bj][m][0], x1 = *(const f32x4*)(x + off + 4) + acc[ai][bj][m][1];
                const float v[8] = {x0[0], x0[1], x0[2], x0[3], x1[0], x1[1], x1[2], x1[3]}; store8(hb + off, v); } }
    }
};
struct ProbMoe1 {
    static constexpr bool HAS_MID = false;
    static constexpr int ESZ = 1, EXA = EXP_T, EXB = EXP_W;
    GridPos g; const unsigned char* T; const unsigned char* w1t; const float* b1; const int* tokof; const int* tiles; const int* ntiles; unsigned char* ACT; const float* rsof;
    HD int K() const { return 1024; }
    HD const unsigned char* A() const { return T; }
    HD size_t arow(const Unit& u, int r) const { const int rr = r < u.nrows ? r : u.nrows - 1; return (size_t)tokof[u.row0 + rr] * 1024; }
    HD const unsigned char* B(const Unit& u) const { return w1t + ((size_t)u.aux * 2048 + (size_t)u.pn * 256) * 1024; }
    HD bool next(int i, Unit& u) const { int t, pn; if (!static_order(g, (long)i * g.G + g.c, *ntiles, 8, t, pn)) return false; const int* tl = tiles + (size_t)t * 4; u.aux = tl[0]; u.row0 = tl[1]; u.nrows = tl[2]; u.pn = pn; return true; }
    HD void epi(const Acc& acc, const Unit& u, int wr, int wc, int fr, int fq) const {
        const int cj = u.pn * 128 + 32 * wc + 8 * fq;
        const float* bg = b1 + (size_t)u.aux * 2048 + cj; const float* bl = bg + 1024;
#if defined(__HIP_DEVICE_COMPILE__)
        _Pragma("unroll") for (int ai = 0; ai < 2; ++ai) _Pragma("unroll") for (int mp = 0; mp < 4; mp += 2) { unsigned px[2], py[2];
            _Pragma("unroll") for (int d = 0; d < 2; ++d) { const int m = mp + d; const int tr = 128 * ai + 64 * wr + 16 * m + fr; const int trc = tr < u.nrows ? tr : 0;
                float gl[8], li[8], a[8]; acc8(acc, ai, 0, m, gl); acc8(acc, ai, 1, m, li); const float rsv = rsof[u.row0 + trc];
                FOR_J8 { const float gv = fminf(gl[j] * rsv + bg[j], 7.0f); const float lv = fminf(fmaxf(li[j] * rsv + bl[j], -7.0f), 7.0f); a[j] = gv * sigmoidf_(1.702f * gv) * (lv + 1.0f) * (float)(1 << EXP_ACT); }
                px[d] = pk4_e4m3(a[0], a[1], a[2], a[3]); py[d] = pk4_e4m3(a[4], a[5], a[6], a[7]); }
            const auto sx = __builtin_amdgcn_permlane16_swap(px[0], px[1], false, false); const auto sy = __builtin_amdgcn_permlane16_swap(py[0], py[1], false, false);
            const int tr = 128 * ai + 64 * wr + 16 * (mp + (fq & 1)) + fr;
            if (tr < u.nrows) *(u32x4*)(ACT + (size_t)(u.row0 + tr) * 1024 + u.pn * 128 + 32 * wc + 8 * (fq & ~1)) = (u32x4){sx[0], sy[0], sx[1], sy[1]}; }
#else
        FOR_AI_M { const int tr = 128 * ai + 64 * wr + 16 * m + fr;
            if (tr < u.nrows) { float gl[8], li[8], a[8]; acc8(acc, ai, 0, m, gl); acc8(acc, ai, 1, m, li); const float rsv = rsof[u.row0 + tr];
                FOR_J8 { const float gv = fminf(gl[j] * rsv + bg[j], 7.0f); const float lv = fminf(fmaxf(li[j] * rsv + bl[j], -7.0f), 7.0f); a[j] = gv * sigmoidf_(1.702f * gv) * (lv + 1.0f); }
                store8_e4m3(ACT + (size_t)(u.row0 + tr) * 1024 + cj, a, (float)(1 << EXP_ACT)); } }
#endif
    }
};
struct ProbMoe2 {
    static constexpr bool HAS_MID = false;
    static constexpr int ESZ = 1, EXA = EXP_ACT, EXB = EXP_W;
    GridPos g; const unsigned char* ACT; const unsigned char* w2t; const float* b2; const float* wof; const int* tiles; const int* ntiles; unsigned char* Y;
    HD int K() const { return 1024; }
    HD const unsigned char* A() const { return ACT; }
    HD size_t arow(const Unit& u, int r) const { return (size_t)(u.row0 + r) * 1024; }
    HD const unsigned char* B(const Unit& u) const { return w2t + ((size_t)u.aux * 1024 + (size_t)u.pn * 256) * 1024; }
    HD bool next(int i, Unit& u) const { int t, pn; if (!static_order(g, (long)i * g.G + g.c, *ntiles, 4, t, pn)) return false; const int* tl = tiles + (size_t)t * 4; u.aux = tl[0]; u.row0 = tl[1]; u.nrows = tl[2]; u.pn = pn; return true; }
    HD void epi(const Acc& acc, const Unit& u, int wr, int wc, int fr, int fq) const {
#if defined(__HIP_DEVICE_COMPILE__)
        _Pragma("unroll") for (int ai = 0; ai < 2; ++ai) _Pragma("unroll") for (int mp = 0; mp < 4; mp += 2) { unsigned px[2][2], py[2][2];
            _Pragma("unroll") for (int d = 0; d < 2; ++d) { const int m = mp + d; const int tr = 128 * ai + 64 * wr + 16 * m + fr; const int trc = tr < u.nrows ? tr : 0; const float w = wof[u.row0 + trc] * (float)(1 << EXP_Y);
                FOR_BJ { const int col = u.pn * 256 + 128 * bj + 32 * wc + 8 * fq; float v[8]; acc8(acc, ai, bj, m, v); const float* bb = b2 + (size_t)u.aux * 1024 + col;
                    FOR_J8 v[j] = w * (v[j] + bb[j]);
                    px[bj][d] = pk4_e4m3(v[0], v[1], v[2], v[3]); py[bj][d] = pk4_e4m3(v[4], v[5], v[6], v[7]); } }
            const int tr = 128 * ai + 64 * wr + 16 * (mp + (fq & 1)) + fr;
            FOR_BJ { const auto sx = __builtin_amdgcn_permlane16_swap(px[bj][0], px[bj][1], false, false); const auto sy = __builtin_amdgcn_permlane16_swap(py[bj][0], py[bj][1], false, false);
                if (tr < u.nrows) *(u32x4*)(Y + (size_t)(u.row0 + tr) * 1024 + u.pn * 256 + 128 * bj + 32 * wc + 8 * (fq & ~1)) = (u32x4){sx[0], sy[0], sx[1], sy[1]}; } }
#else
        FOR_AI_M { const int tr = 128 * ai + 64 * wr + 16 * m + fr;
            if (tr < u.nrows) { const float w = wof[u.row0 + tr];
                FOR_BJ { const int col = u.pn * 256 + 128 * bj + 32 * wc + 8 * fq; float v[8]; acc8(acc, ai, bj, m, v); const float* bb = b2 + (size_t)u.aux * 1024 + col;
                    FOR_J8 v[j] = w * (v[j] + bb[j]);
                    store8_e4m3(Y + (size_t)(u.row0 + tr) * 1024 + col, v, (float)(1 << EXP_Y)); } } }
#endif
    }
};

HD void ld4(const bf16_t* p, float* v) { const unsigned long long w = *(const unsigned long long*)p;
    v[0] = __builtin_bit_cast(float, (unsigned)(w << 16)); v[1] = __builtin_bit_cast(float, (unsigned)w & 0xffff0000u);
    v[2] = __builtin_bit_cast(float, (unsigned)(w >> 32) << 16); v[3] = __builtin_bit_cast(float, (unsigned)(w >> 32) & 0xffff0000u); }
HD void ld4(const unsigned char* p, float* v) { const unsigned w = *(const unsigned*)p; v[0] = e4m32f((unsigned char)w); v[1] = e4m32f((unsigned char)(w >> 8)); v[2] = e4m32f((unsigned char)(w >> 16)); v[3] = e4m32f((unsigned char)(w >> 24)); }
template <class P> HD void ref_gemm_thread(const P& p, const Unit& u, int tid, Acc& acc, bool keep = false) {
    const int wid = tid >> 6, lane = tid & 63, wr = wid >> 2, wc = wid & 3, fr = lane & 15, fq = lane >> 4;
    const int K = p.K(); const auto* A = p.A(); const auto* B = p.B(u);
#pragma unroll
    for (int ai = 0; ai < 2; ++ai) {
        if (!keep) {
#pragma unroll
        for (int bj = 0; bj < 2; ++bj)
#pragma unroll
            for (int m = 0; m < 4; ++m)
#pragma unroll
                for (int n = 0; n < 2; ++n) acc[ai][bj][m][n] = (f32x4){0.f, 0.f, 0.f, 0.f}; }
        size_t ao[4]; bool valid[4];
#pragma unroll
        for (int m = 0; m < 4; ++m) { const int tr = 128 * ai + 64 * wr + 16 * m + fr; valid[m] = tr < u.nrows; ao[m] = p.arow(u, tr); }
#pragma unroll 1
        for (int k0 = 0; k0 < K; k0 += 4) {
            float a[4][4];
#pragma unroll
            for (int m = 0; m < 4; ++m) { if (valid[m]) ld4(A + ao[m] + k0, a[m]); else { a[m][0] = a[m][1] = a[m][2] = a[m][3] = 0.f; } }
#pragma unroll
            for (int bj = 0; bj < 2; ++bj)
#pragma unroll
                for (int n = 0; n < 2; ++n)
#pragma unroll
                    for (int r = 0; r < 4; ++r) {
                        const int col = 128 * bj + 32 * wc + 8 * fq + 4 * n + r; float b[4]; ld4(B + (size_t)col * K + k0, b);
#pragma unroll
                        for (int m = 0; m < 4; ++m) acc[ai][bj][m][n][r] += a[m][0] * b[0] + a[m][1] * b[1] + a[m][2] * b[2] + a[m][3] * b[3];
                    }
        }
        if (P::EXA + P::EXB != 0) { const float sc = 1.0f / (float)(1 << (P::EXA + P::EXB));
#pragma unroll
            for (int bj = 0; bj < 2; ++bj)
#pragma unroll
                for (int m = 0; m < 4; ++m)
#pragma unroll
                    for (int n = 0; n < 2; ++n) acc[ai][bj][m][n] *= sc; }
    }
}

template <int DQK, int DV> HD void ref_attn_row(const bf16_t* q, const bf16_t* k0, int ldk, const bf16_t* v0, int ldv, bf16_t* o, int qpos, float scale) {
    float qf[DQK], of[DV];
#pragma unroll
    for (int c = 0; c < DQK; c += 8) load8(q + c, qf + c);
#pragma unroll
    for (int d = 0; d < DV; ++d) of[d] = 0.f;
    float mx = -INFINITY, l = 0.f;
    for (int j = 0; j <= qpos; ++j) {
        const bf16_t* kr = k0 + (size_t)j * ldk; float s = 0.f;
#pragma unroll
        for (int c = 0; c < DQK; c += 8) { float kf[8]; load8(kr + c, kf);
#pragma unroll
            for (int t = 0; t < 8; ++t) s += qf[c + t] * kf[t]; }
        s *= scale;
        if (s > mx) { const float al = expf(mx - s); l *= al;
#pragma unroll
            for (int d = 0; d < DV; ++d) of[d] *= al;
            mx = s; }
        const float pj = expf(s - mx); l += pj;
        const bf16_t* vr = v0 + (size_t)j * ldv;
#pragma unroll
        for (int c = 0; c < DV; c += 8) { float vf[8]; load8(vr + c, vf);
#pragma unroll
            for (int t = 0; t < 8; ++t) of[c + t] += pj * vf[t]; }
    }
    const float il = 1.0f / l;
#pragma unroll
    for (int d = 0; d < DV; ++d) of[d] *= il;
#pragma unroll
    for (int c = 0; c < DV; c += 8) store8(o + c, of + c);
}
struct AttnMla { const bf16_t* QA; const bf16_t* KV; bf16_t* OA; };
HD void ref_attn_mla_item(const Params& p, long item) {
    const int pos = (int)(item % SEQ), h = (int)((item / SEQ) & 7), b = (int)(item / SEQ / 8); const size_t tok0 = (size_t)b * SEQ;
    ref_attn_row<96, 64>(wsp<bf16_t>(p, WS_QA) + (tok0 + pos) * QA_W + h * 96, wsp<bf16_t>(p, WS_KV) + tok0 * KV_W + h * 160, KV_W,
                         wsp<bf16_t>(p, WS_KV) + tok0 * KV_W + h * 160 + 96, KV_W, wsp<bf16_t>(p, WS_OA) + (tok0 + pos) * 512 + h * 64, pos, LN2);
}
HD void ref_attn_diff_item(const Params& p, long item) {
    const int pos = (int)(item % SEQ), h = (int)((item / SEQ) & 7), b = (int)(item / SEQ / 8); const size_t tok0 = (size_t)b * SEQ;
    const bf16_t* proj = wsp<bf16_t>(p, WS_PROJ);
    ref_attn_row<64, 128>(proj + (tok0 + pos) * PROJ_W + PC_DQ + h * 64, proj + tok0 * PROJ_W + PC_DK + h * 64, PROJ_W,
                          proj + tok0 * PROJ_W + PC_DV + (h >> 1) * 128, PROJ_W, wsp<bf16_t>(p, WS_OD) + (tok0 + pos) * OD_W + h * 128, pos, LN2);
}

HD ProbInProj mk_inproj(const Params& p, GridPos g) { return ProbInProj{g, wsp<ProbInProj::el_t>(p, WS_XN), wsp<ProbInProj::el_t>(p, WS_WIN), wsp<bf16_t>(p, WS_PROJ), wsp<float>(p, WS_SSP)}; }
HD ProbInProjG mk_inprojg(const Params& p, GridPos g) { return ProbInProjG{g, wsp<unsigned char>(p, WS_XN8), wsp<unsigned char>(p, WS_WIN8), wsp<bf16_t>(p, WS_PROJ)}; }
HD ProbUpQ mk_upq(const Params& p, GridPos g) { return ProbUpQ{g, wsp<bf16_t>(p, WS_PROJ), wsp<bf16_t>(p, WS_WUQ), wsp<bf16_t>(p, WS_QA)}; }
HD ProbUpKV mk_upkv(const Params& p, GridPos g) { return ProbUpKV{g, wsp<bf16_t>(p, WS_PROJ), wsp<bf16_t>(p, WS_WUKV), wsp<bf16_t>(p, WS_KV), wsp<float>(p, WS_SSP)}; }
HD ProbBranch mk_branch(const Params& p, GridPos g) { constexpr size_t lo = WS_OA < WS_OB ? WS_OA : WS_OB; return ProbBranch{g, wsp<bf16_t>(p, lo), (WS_OA - lo) / 2, (WS_OB - lo) / 2, wsp<bf16_t>(p, WS_WBA), wsp<bf16_t>(p, WS_WBB), wsp<bf16_t>(p, WS_PROJ), wsp<bf16_t>(p, WS_MERGED)}; }
HD ProbOut mk_out(const Params& p, GridPos g) { return ProbOut{g, wsp<bf16_t>(p, WS_MERGED), wsp<bf16_t>(p, WS_WOUT), p.x, wsp<bf16_t>(p, WS_HB)}; }
HD ProbMoe1 mk_moe1(const Params& p, GridPos g, int hf) { return ProbMoe1{g, wsp<unsigned char>(p, WS_T), wsp<unsigned char>(p, WS_W1), p.b1, wsp<int>(p, WS_TOKOF) + (size_t)hf * HALF_SLOTS,
    wsp<int>(p, WS_MISC + MS_TILES) + (size_t)hf * MAX_TILES * 4, wsp<int>(p, WS_MISC + MS_NTILES) + hf, wsp<unsigned char>(p, WS_ACT), wsp<float>(p, WS_RSOF) + (size_t)hf * HALF_SLOTS}; }
HD ProbMoe2 mk_moe2(const Params& p, GridPos g, int hf) { return ProbMoe2{g, wsp<unsigned char>(p, WS_ACT), wsp<unsigned char>(p, WS_W2), p.b2, wsp<float>(p, WS_WOF) + (size_t)hf * HALF_SLOTS,
    wsp<int>(p, WS_MISC + MS_TILES) + (size_t)hf * MAX_TILES * 4, wsp<int>(p, WS_MISC + MS_NTILES) + hf, wsp<unsigned char>(p, WS_Y)}; }


#define LAS __attribute__((address_space(3)))
constexpr int NWAVES = 8, NTHREADS = NWAVES * 64;
constexpr int RING_BYTES = 131072;
constexpr int MISC_OFF = RING_BYTES + 320;
constexpr int LDS_BYTES = 147456;

#define XB_TMO      128
#define XB_XCNT(j)  (256  + 64 * (j))
#define XB_XSUB(j)  (1280 + 64 * (j))
#define XB_XGEN(j)  (2304 + 64 * (j))
#define XB_TOP      3328
#define XB_TOPGEN   3392
#define XCD_BAR_WORDS 3456
#define XB_SPIN_CAP (1u << 22)
__device__ __forceinline__ unsigned xb_ld(unsigned* p)              { return __hip_atomic_load(p, __ATOMIC_RELAXED, __HIP_MEMORY_SCOPE_AGENT); }
__device__ __forceinline__ unsigned xb_add(unsigned* p, unsigned v) { return __hip_atomic_fetch_add(p, v, __ATOMIC_RELAXED, __HIP_MEMORY_SCOPE_AGENT); }
__device__ __forceinline__ unsigned xb_xcc_id() { return (unsigned)__builtin_amdgcn_s_getreg((3 << 11) | 20) & 0xFu; }
#define XB_SPIN(cond, bar) do { unsigned _sp = 0; while (cond) { __builtin_amdgcn_s_sleep(1); \
    if ((++_sp & 255u) == 0u) { if (xb_ld(&(bar)[XB_TMO])) break; if (_sp > XB_SPIN_CAP) { atomicAdd(&(bar)[XB_TMO], 1u); break; } } } } while (0)
struct XcdBarrier { unsigned* bar; unsigned x; volatile LAS unsigned* st; };
__device__ __forceinline__ XcdBarrier xcd_barrier_post(unsigned* bar, volatile LAS unsigned* st) {
    XcdBarrier b; b.bar = bar; b.x = xb_xcc_id(); b.st = st;
    if (threadIdx.x == 0) (void)xb_add(&bar[XB_XCNT(b.x)], 1u);
    return b;
}
__device__ __forceinline__ void xcd_barrier_complete(unsigned* bar, unsigned x, unsigned& nloc, unsigned& nx) {
    const unsigned G = gridDim.x * gridDim.y * gridDim.z;
    unsigned sum, cnt, mine, sp = 0u;
    for (;;) {
        sum = 0u; cnt = 0u; mine = 0u;
#pragma unroll
        for (unsigned j = 0; j < 16; ++j) { const unsigned c = xb_ld(&bar[XB_XCNT(j)]); sum += c; cnt += (c > 0u) ? 1u : 0u; mine = (j == x) ? c : mine; }
        if (sum == G) break;
        __builtin_amdgcn_s_sleep(1);
        if ((++sp & 255u) == 0u) { if (xb_ld(&bar[XB_TMO])) break; if (sp > XB_SPIN_CAP) { atomicAdd(&bar[XB_TMO], 1u); break; } }
    }
    nloc = mine > 0u ? mine : 1u; nx = cnt > 0u ? cnt : 1u;
}
__device__ __forceinline__ void xcd_barrier(const XcdBarrier& b) {
    asm volatile("s_waitcnt vmcnt(0)" ::: "memory");
    __syncthreads();
    if (threadIdx.x == 0) {
        unsigned* bar = b.bar;
        __builtin_amdgcn_s_waitcnt(0);
        unsigned nloc = b.st[0], nx = b.st[1];
        if (nloc == 0u) { xcd_barrier_complete(bar, b.x, nloc, nx); b.st[0] = nloc; b.st[1] = nx; }
        const unsigned old = xb_add(&bar[XB_XSUB(b.x)], 1u);
        const unsigned gen = old / nloc;
        if (old + 1u == (gen + 1u) * nloc) {
            __builtin_amdgcn_fence(__ATOMIC_RELEASE, "agent");
            asm volatile("s_waitcnt vmcnt(0)" ::: "memory");
            const unsigned og = xb_add(&bar[XB_TOP], 1u);
            const unsigned tg = og / nx;
            if (og + 1u == (tg + 1u) * nx) xb_add(&bar[XB_TOPGEN], 1u);
            else XB_SPIN(xb_ld(&bar[XB_TOPGEN]) == tg, bar);
            __builtin_amdgcn_fence(__ATOMIC_ACQUIRE, "agent");
            xb_add(&bar[XB_XGEN(b.x)], 1u);
            asm volatile("s_waitcnt vmcnt(0)" ::: "memory");
        } else {
            XB_SPIN(xb_ld(&bar[XB_XGEN(b.x)]) == gen, bar);
            __builtin_amdgcn_fence(__ATOMIC_ACQUIRE, "agent");
            asm volatile("s_waitcnt vmcnt(0)" ::: "memory");
        }
    }
    __syncthreads();
}

namespace pg8 {
typedef short bf16x8 __attribute__((ext_vector_type(8)));
constexpr int BK = 64, HALF = 128, HTB = HALF * BK * 2, STAGE_BYTES = 8 * HTB;
__device__ __forceinline__ int lds_byte(int r, int c) { const int ch = c >> 3, pc = r >> 3; return pc * 1024 + (ch >> 2) * 512 + (r & 7) * 64 + (((ch & 3) ^ ((pc & 1) << 1)) << 4); }
__device__ __forceinline__ void stage_rc(int b, int& R, int& C) { const int pc = b >> 10, j = (b >> 4) & 63, r = (j >> 2) & 7, ch = ((j >> 5) << 2) | ((j & 3) ^ ((pc & 1) << 1)); R = pc * 8 + r; C = ch * 8; }
__device__ __forceinline__ int perm32(int rho) { const int n = rho >> 4, i = rho & 15; return 8 * (i >> 2) + 4 * n + (i & 3); }

template <class P, int VAR = 0>
__device__ __forceinline__ void gemm_phase(LAS unsigned char* lds, const P& pr, const unsigned char* wsbase) {
    int tid_ = threadIdx.x; asm volatile("" : "+v"(tid_));
    const int tid = tid_, wid = __builtin_amdgcn_readfirstlane(tid >> 6), lane = tid & 63, wr = wid >> 2, wc = wid & 3, fr = lane & 15, fq = lane >> 4;
    constexpr int ESZ = P::ESZ;
    const int KB = pr.K() * ESZ, nt = KB / (BK * 2);
    int Rr[2], Cc[2]; unsigned voffB[2];
#pragma unroll
    for (int i = 0; i < 2; ++i) { int R, C; stage_rc(tid * 16 + i * 8192, R, C); Rr[i] = R; Cc[i] = C; const int Rb = (R & ~31) + perm32(R & 31); voffB[i] = (unsigned)(Rb * KB + C * 2); }
    const size_t kstep = (size_t)(BK * 2);
    const size_t hstepB = (size_t)HALF * KB;
    const unsigned ldsw = (unsigned)wid * 1024u;
    const int aoff = lds_byte(wr * 64 + fr, fq * 8), boff = lds_byte(wc * 32 + fr, fq * 8);
    const __amdgpu_buffer_rsrc_t rsrc = __builtin_amdgcn_make_buffer_rsrc((void*)wsbase, 0, 0xffffffffu, 0x00020000);
    const unsigned Aoff = (unsigned)((const unsigned char*)pr.A() - wsbase);
    typedef int v4i_t __attribute__((ext_vector_type(4))); typedef int v8i_t __attribute__((ext_vector_type(8)));
    const int scale_w = (127 - P::EXB) * 0x01010101, scale_x = (127 - P::EXA) * 0x01010101;
#define PG8_SA(b, h) (((b) * 2 + (h)) * HTB)
#define PG8_SB(b, h) ((4 + (b) * 2 + (h)) * HTB)
#define PG8_STAGE_A(bufoff, offs, kb) do { if constexpr (VAR != 3) _Pragma("unroll") for (int _i = 0; _i < 2; ++_i) \
        __builtin_amdgcn_raw_ptr_buffer_load_lds(rsrc, (LAS unsigned*)(lds + (bufoff) + ldsw + _i * 8192), 16, (offs)[_i], Aoff + (unsigned)(kb), 0, 0); } while (0)
#define PG8_STAGE_B(bufoff, gbase) do { if constexpr (VAR != 3) _Pragma("unroll") for (int _i = 0; _i < 2; ++_i) \
        __builtin_amdgcn_raw_ptr_buffer_load_lds(rsrc, (LAS unsigned*)(lds + (bufoff) + ldsw + _i * 8192), 16, voffB[_i], (unsigned)(gbase), 0, 0); } while (0)
#define PG8_LDA(dst, b, h) do { if constexpr (VAR == 2) { } else if constexpr (ESZ == 2) { _Pragma("unroll") for (int m = 0; m < 4; ++m) _Pragma("unroll") for (int k = 0; k < 2; ++k) dst[m][k] = *(const LAS bf16x8*)(lds + PG8_SA(b, h) + aoff + m * 2048 + k * 512); } \
        else { _Pragma("unroll") for (int m = 0; m < 4; ++m) { const v4i_t _lo = *(const LAS v4i_t*)(lds + PG8_SA(b, h) + aoff + m * 2048), _hi = *(const LAS v4i_t*)(lds + PG8_SA(b, h) + aoff + m * 2048 + 512); \
            dst##8[m] = __builtin_shufflevector(_lo, _hi, 0, 1, 2, 3, 4, 5, 6, 7); } } } while (0)
#define PG8_LDB(dst, b, h) do { if constexpr (VAR == 2) { } else if constexpr (ESZ == 2) { _Pragma("unroll") for (int n = 0; n < 2; ++n) _Pragma("unroll") for (int k = 0; k < 2; ++k) dst[n][k] = *(const LAS bf16x8*)(lds + PG8_SB(b, h) + boff + n * 2048 + k * 512); } \
        else { _Pragma("unroll") for (int n = 0; n < 2; ++n) { const v4i_t _lo = *(const LAS v4i_t*)(lds + PG8_SB(b, h) + boff + n * 2048), _hi = *(const LAS v4i_t*)(lds + PG8_SB(b, h) + boff + n * 2048 + 512); \
            dst##8[n] = __builtin_shufflevector(_lo, _hi, 0, 1, 2, 3, 4, 5, 6, 7); } } } while (0)
#define PG8_MMA(ai, bj, At, Bt) do { if constexpr (VAR != 4) __builtin_amdgcn_s_setprio(1); \
        if constexpr (VAR == 6) { __builtin_amdgcn_s_sleep(8); } \
        if constexpr (VAR == 1 || VAR == 6) { _Pragma("unroll") for (int m = 0; m < 4; ++m) _Pragma("unroll") for (int k = 0; k < 2; ++k) asm volatile("" :: "v"(At[m][k])); _Pragma("unroll") for (int n = 0; n < 2; ++n) _Pragma("unroll") for (int k = 0; k < 2; ++k) asm volatile("" :: "v"(Bt[n][k])); } \
        else if constexpr (ESZ == 2) { _Pragma("unroll") for (int m = 0; m < 4; ++m) _Pragma("unroll") for (int n = 0; n < 2; ++n) _Pragma("unroll") for (int k = 0; k < 2; ++k) \
            acc[ai][bj][m][n] = __builtin_amdgcn_mfma_f32_16x16x32_bf16(Bt[n][k], At[m][k], acc[ai][bj][m][n], 0, 0, 0); } \
        else { _Pragma("unroll") for (int m = 0; m < 4; ++m) _Pragma("unroll") for (int n = 0; n < 2; ++n) \
            asm volatile("v_mfma_scale_f32_16x16x128_f8f6f4 %0, %1, %2, %0, %3, %4 op_sel_hi:[0,0,0]" : "+v"(acc[ai][bj][m][n]) : "v"(Bt##8[n]), "v"(At##8[m]), "v"(scale_w), "v"(scale_x)); } \
        if constexpr (VAR != 4) __builtin_amdgcn_s_setprio(0); } while (0)
#define PG8_WAIT_V(n) asm volatile("s_waitcnt vmcnt(" #n ")" ::: "memory")
#define PG8_WAIT_L(n) asm volatile("s_waitcnt lgkmcnt(" #n ")" ::: "memory")
#define PG8_BAR do { if constexpr (VAR != 5) __builtin_amdgcn_s_barrier(); } while (0)
#define PG8_SCHED __builtin_amdgcn_sched_barrier(0)
#define PG8_FILL(u, o) do { _Pragma("unroll") for (int _h = 0; _h < 2; ++_h) _Pragma("unroll") for (int _i = 0; _i < 2; ++_i) (o)[_h][_i] = (unsigned)(pr.arow((u), _h * HALF + Rr[_i]) * ESZ + (size_t)Cc[_i] * 2); } while (0)
    Unit cur, nxt; int ui = 0;
    if (!pr.next(0, cur)) return;
    Acc acc;
#pragma unroll
    for (int a = 0; a < 2; ++a)
#pragma unroll
        for (int b = 0; b < 2; ++b)
#pragma unroll
            for (int m = 0; m < 4; ++m)
#pragma unroll
                for (int n = 0; n < 2; ++n) acc[a][b][m][n] = (f32x4){0.f, 0.f, 0.f, 0.f};
    bf16x8 At[4][2] = {}, B0[2][2] = {}, B1[2][2] = {}; v8i_t At8[4] = {}, B08[2] = {}, B18[2] = {};
    unsigned curA[2][2], nxtA[2][2];
    PG8_FILL(cur, curA);
    unsigned cB = (unsigned)((const unsigned char*)pr.B(cur) - wsbase);
    PG8_STAGE_B(PG8_SB(0, 0), cB); PG8_STAGE_B(PG8_SB(0, 1), cB + (unsigned)hstepB); PG8_STAGE_A(PG8_SA(0, 0), curA[0], 0); PG8_STAGE_A(PG8_SA(0, 1), curA[1], 0);
    if (wr == 1 && VAR != 7) PG8_BAR;
    PG8_WAIT_V(2); PG8_BAR;
    PG8_STAGE_B(PG8_SB(1, 0), cB + (unsigned)kstep); PG8_STAGE_A(PG8_SA(1, 0), curA[0], kstep); PG8_STAGE_B(PG8_SB(1, 1), cB + (unsigned)(hstepB + kstep));
    PG8_WAIT_V(6); PG8_BAR;
    for (;;) {
        const bool has_next = pr.next(ui + 1, nxt);
        unsigned nB = cB;
        if (has_next) { PG8_FILL(nxt, nxtA); nB = (unsigned)((const unsigned char*)pr.B(nxt) - wsbase); }
        else {
#pragma unroll
            for (int h = 0; h < 2; ++h)
#pragma unroll
                for (int i = 0; i < 2; ++i) nxtA[h][i] = curA[h][i]; }
#pragma unroll 1
        for (int t = 0; t < nt; t += 2) {
            const bool last = (t == nt - 2);
            const size_t k1 = (size_t)(t + 1) * kstep;
            const size_t k2 = last ? 0 : (size_t)(t + 2) * kstep, k3 = k2 + kstep;
            unsigned a2o[2][2];
#pragma unroll
            for (int h = 0; h < 2; ++h)
#pragma unroll
                for (int i = 0; i < 2; ++i) a2o[h][i] = last ? nxtA[h][i] : curA[h][i];
            const unsigned b2 = last ? nB : cB + (unsigned)((size_t)(t + 2) * kstep), b3 = b2 + (unsigned)kstep;
            PG8_LDB(B0, 0, 0); PG8_LDB(B1, 0, 1); PG8_SCHED; PG8_LDA(At, 0, 0); PG8_STAGE_A(PG8_SA(1, 1), curA[1], k1);
            PG8_WAIT_V(8); PG8_WAIT_L(0); PG8_BAR; PG8_MMA(0, 0, At, B0); PG8_MMA(0, 1, At, B1); PG8_BAR; PG8_SCHED;
            PG8_LDA(At, 0, 1); PG8_STAGE_B(PG8_SB(0, 0), b2); PG8_STAGE_B(PG8_SB(0, 1), b2 + (unsigned)hstepB); PG8_STAGE_A(PG8_SA(0, 0), a2o[0], k2);
            PG8_WAIT_V(8); PG8_WAIT_L(0); PG8_BAR; PG8_MMA(1, 0, At, B0); PG8_MMA(1, 1, At, B1); PG8_BAR; PG8_SCHED;
            PG8_LDB(B0, 1, 0); PG8_LDB(B1, 1, 1); PG8_SCHED; PG8_LDA(At, 1, 0); PG8_STAGE_A(PG8_SA(0, 1), a2o[1], k2);
            PG8_WAIT_V(8); PG8_WAIT_L(0); PG8_BAR; PG8_MMA(0, 0, At, B0); PG8_MMA(0, 1, At, B1); PG8_BAR; PG8_SCHED;
            PG8_LDA(At, 1, 1); PG8_STAGE_B(PG8_SB(1, 0), b3); PG8_STAGE_B(PG8_SB(1, 1), b3 + (unsigned)hstepB); PG8_STAGE_A(PG8_SA(1, 0), a2o[0], k3);
            PG8_WAIT_V(8); PG8_WAIT_L(0); PG8_BAR; PG8_MMA(1, 0, At, B0); PG8_MMA(1, 1, At, B1); PG8_BAR; PG8_SCHED;
        }
        if (wr == 0 && VAR != 7) PG8_BAR;
        bool mid = false;
        if constexpr (P::HAS_MID) { mid = pr.is_mid(cur); if (mid) pr.epi_mid(acc, cur, wr, wc, fr, fq); else pr.epi(acc, cur, wr, wc, fr, fq); } else pr.epi(acc, cur, wr, wc, fr, fq);
        if (!has_next) break;
        if (!mid)
#pragma unroll
        for (int a = 0; a < 2; ++a)
#pragma unroll
            for (int b = 0; b < 2; ++b)
#pragma unroll
                for (int m = 0; m < 4; ++m)
#pragma unroll
                    for (int n = 0; n < 2; ++n) acc[a][b][m][n] = (f32x4){0.f, 0.f, 0.f, 0.f};
        cur = nxt; cB = nB; ++ui;
#pragma unroll
        for (int h = 0; h < 2; ++h)
#pragma unroll
            for (int i = 0; i < 2; ++i) curA[h][i] = nxtA[h][i];
        if (wr == 1 && VAR != 7) PG8_BAR;
    }
    PG8_WAIT_V(0);
    PG8_BAR;
#undef PG8_SA
#undef PG8_SB
#undef PG8_STAGE_A
#undef PG8_STAGE_B
#undef PG8_LDA
#undef PG8_LDB
#undef PG8_MMA
#undef PG8_WAIT_V
#undef PG8_WAIT_L
#undef PG8_BAR
#undef PG8_SCHED
#undef PG8_FILL
}

template <class P, int VAR = 0>
__device__ __forceinline__ void gemm_phase_pipe(LAS unsigned char* lds, const P& pr, const unsigned char* wsbase) {
    static_assert(P::ESZ == 2, "bf16 operands");
    int tid_ = threadIdx.x; asm volatile("" : "+v"(tid_));
    const int tid = tid_, wid = __builtin_amdgcn_readfirstlane(tid >> 6), lane = tid & 63, wr = wid >> 2, wc = wid & 3, fr = lane & 15, fq = lane >> 4;
    const int KB = pr.K() * 2, nt = KB / 128;
    int Rr[2], Cc[2]; unsigned voffB[2];
#pragma unroll
    for (int i = 0; i < 2; ++i) { int R, C; stage_rc(tid * 16 + i * 8192, R, C); Rr[i] = R; Cc[i] = C; const int Rb = (R & ~31) + perm32(R & 31); voffB[i] = (unsigned)(Rb * KB + C * 2); }
    const unsigned hstepB = (unsigned)(HALF * KB);
    const unsigned ldsw = (unsigned)wid * 1024u;
    const int aoff = lds_byte(wr * 64 + fr, fq * 8), boff = lds_byte(wc * 32 + fr, fq * 8);
    const __amdgpu_buffer_rsrc_t rsrc = __builtin_amdgcn_make_buffer_rsrc((void*)wsbase, 0, 0xffffffffu, 0x00020000);
    const unsigned Aoff = (unsigned)((const unsigned char*)pr.A() - wsbase);
#define PP_SA(b, h) (((b) * 2 + (h)) * HTB)
#define PP_SB(b, h) ((4 + (b) * 2 + (h)) * HTB)
#define PP_DMA(ldsoff, voff, soff) __builtin_amdgcn_raw_ptr_buffer_load_lds(rsrc, (LAS unsigned*)(lds + (ldsoff) + ldsw), 16, (voff), (soff), 0, 0)
#define PP_STAGE(b, ao, kb, bb) do { _Pragma("unroll") for (int _h = 0; _h < 2; ++_h) _Pragma("unroll") for (int _i = 0; _i < 2; ++_i) { \
        PP_DMA(PP_SA(b, _h) + _i * 8192, (ao)[_h][_i], Aoff + (unsigned)(kb)); PP_DMA(PP_SB(b, _h) + _i * 8192, voffB[_i], (bb) + (unsigned)(kb) + _h * hstepB); } } while (0)
#define PP_LDA(dst, b, ai, k) do { if constexpr (VAR != 2) _Pragma("unroll") for (int m = 0; m < 4; ++m) dst[m] = *(const LAS bf16x8*)(lds + PP_SA(b, ai) + aoff + m * 2048 + (k) * 512); } while (0)
#define PP_LDB(dst, b, k) do { if constexpr (VAR != 2) _Pragma("unroll") for (int bj = 0; bj < 2; ++bj) _Pragma("unroll") for (int n = 0; n < 2; ++n) dst[bj][n] = *(const LAS bf16x8*)(lds + PP_SB(b, bj) + boff + n * 2048 + (k) * 512); } while (0)
#define PP_MMA(ai, Af, Bf) do { if constexpr (VAR == 1) { _Pragma("unroll") for (int m = 0; m < 4; ++m) asm volatile("" :: "v"(Af[m])); _Pragma("unroll") for (int bj = 0; bj < 2; ++bj) _Pragma("unroll") for (int n = 0; n < 2; ++n) asm volatile("" :: "v"(Bf[bj][n])); } \
        else _Pragma("unroll") for (int m = 0; m < 4; ++m) _Pragma("unroll") for (int bj = 0; bj < 2; ++bj) _Pragma("unroll") for (int n = 0; n < 2; ++n) \
        acc[ai][bj][m][n] = __builtin_amdgcn_mfma_f32_16x16x32_bf16(Bf[bj][n], Af[m], acc[ai][bj][m][n], 0, 0, 0); } while (0)
#define PP_FILL(u, o) do { _Pragma("unroll") for (int _h = 0; _h < 2; ++_h) _Pragma("unroll") for (int _i = 0; _i < 2; ++_i) (o)[_h][_i] = (unsigned)(pr.arow((u), _h * HALF + Rr[_i]) * 2 + (size_t)Cc[_i] * 2); } while (0)
#define PP_SCHED __builtin_amdgcn_sched_barrier(0)
    Unit cur, nxt; int ui = 0;
    if (!pr.next(0, cur)) return;
    Acc acc;
#pragma unroll
    for (int a = 0; a < 2; ++a)
#pragma unroll
        for (int b = 0; b < 2; ++b)
#pragma unroll
            for (int m = 0; m < 4; ++m)
#pragma unroll
                for (int n = 0; n < 2; ++n) acc[a][b][m][n] = (f32x4){0.f, 0.f, 0.f, 0.f};
    bf16x8 Ax[4] = {}, Ay[4] = {}, Bx[2][2] = {}, By[2][2] = {};
    unsigned curA[2][2], nxtA[2][2];
    PP_FILL(cur, curA);
    unsigned cB = (unsigned)((const unsigned char*)pr.B(cur) - wsbase);
    PP_STAGE(0, curA, 0, cB); PP_STAGE(1, curA, 128, cB);
    asm volatile("s_waitcnt vmcnt(8)" ::: "memory"); __builtin_amdgcn_s_barrier();
    PP_LDA(Ax, 0, 0, 0); PP_LDB(Bx, 0, 0);
    for (;;) {
        const bool has_next = pr.next(ui + 1, nxt);
        unsigned nB = cB;
        if (has_next) { PP_FILL(nxt, nxtA); nB = (unsigned)((const unsigned char*)pr.B(nxt) - wsbase); }
        else {
#pragma unroll
            for (int h = 0; h < 2; ++h)
#pragma unroll
                for (int i = 0; i < 2; ++i) nxtA[h][i] = curA[h][i]; }
#pragma unroll 1
        for (int t = 0; t < nt; t += 2) {
            { const bool wrap = (t + 2 >= nt); const unsigned kb2 = wrap ? (unsigned)(t + 2 - nt) * 128u : (unsigned)(t + 2) * 128u; const unsigned b2 = wrap ? nB : cB;
              unsigned a2o[2][2];
#pragma unroll
              for (int h = 0; h < 2; ++h)
#pragma unroll
                  for (int i = 0; i < 2; ++i) a2o[h][i] = wrap ? nxtA[h][i] : curA[h][i];
              PP_LDA(Ay, 0, 1, 0); PP_MMA(0, Ax, Bx); PP_SCHED;
              PP_LDA(Ax, 0, 0, 1); PP_LDB(By, 0, 1); PP_MMA(1, Ay, Bx); PP_SCHED;
              PP_LDA(Ay, 0, 1, 1); PP_MMA(0, Ax, By); PP_SCHED;
              asm volatile("s_waitcnt vmcnt(0) lgkmcnt(0)" ::: "memory"); __builtin_amdgcn_s_barrier();
              PP_STAGE(0, a2o, kb2, b2);
              PP_LDA(Ax, 1, 0, 0); PP_LDB(Bx, 1, 0); PP_MMA(1, Ay, By); PP_SCHED; }
            { const bool wrap = (t + 3 >= nt); const unsigned kb3 = wrap ? (unsigned)(t + 3 - nt) * 128u : (unsigned)(t + 3) * 128u; const unsigned b3 = wrap ? nB : cB;
              unsigned a3o[2][2];
#pragma unroll
              for (int h = 0; h < 2; ++h)
#pragma unroll
                  for (int i = 0; i < 2; ++i) a3o[h][i] = wrap ? nxtA[h][i] : curA[h][i];
              PP_LDA(Ay, 1, 1, 0); PP_MMA(0, Ax, Bx); PP_SCHED;
              PP_LDA(Ax, 1, 0, 1); PP_LDB(By, 1, 1); PP_MMA(1, Ay, Bx); PP_SCHED;
              PP_LDA(Ay, 1, 1, 1); PP_MMA(0, Ax, By); PP_SCHED;
              asm volatile("s_waitcnt vmcnt(0) lgkmcnt(0)" ::: "memory"); __builtin_amdgcn_s_barrier();
              PP_STAGE(1, a3o, kb3, b3);
              PP_LDA(Ax, 0, 0, 0); PP_LDB(Bx, 0, 0); PP_MMA(1, Ay, By); PP_SCHED; }
        }
        pr.epi(acc, cur, wr, wc, fr, fq);
        if (!has_next) break;
#pragma unroll
        for (int a = 0; a < 2; ++a)
#pragma unroll
            for (int b = 0; b < 2; ++b)
#pragma unroll
                for (int m = 0; m < 4; ++m)
#pragma unroll
                    for (int n = 0; n < 2; ++n) acc[a][b][m][n] = (f32x4){0.f, 0.f, 0.f, 0.f};
        cur = nxt; cB = nB; ++ui;
#pragma unroll
        for (int h = 0; h < 2; ++h)
#pragma unroll
            for (int i = 0; i < 2; ++i) curA[h][i] = nxtA[h][i];
    }
    asm volatile("s_waitcnt vmcnt(0) lgkmcnt(0)" ::: "memory");
    __builtin_amdgcn_s_barrier();
#undef PP_SA
#undef PP_SB
#undef PP_DMA
#undef PP_STAGE
#undef PP_LDA
#undef PP_LDB
#undef PP_MMA
#undef PP_FILL
#undef PP_SCHED
}

template <class P, int VAR = 0>
__device__ __forceinline__ void gemm_phase_pipe2(LAS unsigned char* lds, const P& pr, const unsigned char* wsbase) {
    static_assert(P::ESZ == 2, "bf16 operands");
    int tid_ = threadIdx.x; asm volatile("" : "+v"(tid_));
    const int tid = tid_, wid = __builtin_amdgcn_readfirstlane(tid >> 6), lane = tid & 63, wr = wid >> 2, wc = wid & 3, fr = lane & 15, fq = lane >> 4;
    const int KB = pr.K() * 2, nk = KB / 64;
    const int srow = lane >> 2, Hs = (0x78 >> (2 * (srow >> 2))) & 3, schunk = (lane & 3) ^ Hs;
    unsigned voffB[2];
#pragma unroll
    for (int i = 0; i < 2; ++i) { const int R = (wid + 8 * i) * 16 + srow; const int Rb = (R & ~31) + perm32(R & 31); voffB[i] = (unsigned)(Rb * KB + schunk * 16); }
    const unsigned ldsw = (unsigned)wid * 1024u;
    const int Hf = (0x78 >> (2 * (fr >> 2))) & 3; const int lofs = (fr * 4 + (fq ^ Hf)) * 16;
    const int aoff = (4 * wr) * 1024 + lofs, boff = 16384 + (2 * wc) * 1024 + lofs;
    const __amdgpu_buffer_rsrc_t rsrc = __builtin_amdgcn_make_buffer_rsrc((void*)wsbase, 0, 0xffffffffu, 0x00020000);
    const unsigned Aoff = (unsigned)((const unsigned char*)pr.A() - wsbase);
#define Q_DMA(ldsoff, voff, soff) do { if constexpr (VAR != 3) __builtin_amdgcn_raw_ptr_buffer_load_lds(rsrc, (LAS unsigned*)(lds + (ldsoff) + ldsw), 16, (voff), (soff), 0, 0); } while (0)
#define Q_STAGE(b, ao, kb, bb) do { _Pragma("unroll") for (int _i = 0; _i < 2; ++_i) { Q_DMA((b) * 32768 + _i * 8192, (ao)[_i], Aoff + (unsigned)(kb)); Q_DMA((b) * 32768 + 16384 + _i * 8192, voffB[_i], (bb) + (unsigned)(kb)); } } while (0)
#define Q_LDA(dst, b, ai) do { if constexpr (VAR != 2) _Pragma("unroll") for (int m = 0; m < 4; ++m) dst[m] = *(const LAS bf16x8*)(lds + (b) * 32768 + aoff + (8 * (ai) + m) * 1024); } while (0)
#define Q_LDB(dst, b) do { if constexpr (VAR != 2) _Pragma("unroll") for (int bj = 0; bj < 2; ++bj) _Pragma("unroll") for (int n = 0; n < 2; ++n) dst[bj][n] = *(const LAS bf16x8*)(lds + (b) * 32768 + boff + (8 * bj + n) * 1024); } while (0)
#define Q_MMA(ai, Af, Bf) do { if constexpr (VAR == 1) { _Pragma("unroll") for (int m = 0; m < 4; ++m) asm volatile("" :: "v"(Af[m])); _Pragma("unroll") for (int bj = 0; bj < 2; ++bj) _Pragma("unroll") for (int n = 0; n < 2; ++n) asm volatile("" :: "v"(Bf[bj][n])); } \
        else _Pragma("unroll") for (int m = 0; m < 4; ++m) _Pragma("unroll") for (int bj = 0; bj < 2; ++bj) _Pragma("unroll") for (int n = 0; n < 2; ++n) \
        acc[ai][bj][m][n] = __builtin_amdgcn_mfma_f32_16x16x32_bf16(Bf[bj][n], Af[m], acc[ai][bj][m][n], 0, 0, 0); } while (0)
#define Q_FILL(u, o) do { _Pragma("unroll") for (int _i = 0; _i < 2; ++_i) (o)[_i] = (unsigned)(pr.arow((u), (wid + 8 * _i) * 16 + srow) * 2 + (size_t)schunk * 16); } while (0)
#define Q_SCHED __builtin_amdgcn_sched_barrier(0)
#define Q_STEP(b, ks, Bc, Bn) do { const int _g = (ks) + 4; const bool _w = _g >= nk; const unsigned _kb = (unsigned)(_w ? _g - nk : _g) * 64u; const unsigned _bb = _w ? nB : cB; \
        unsigned _ao[2]; _ao[0] = _w ? nxtA[0] : curA[0]; _ao[1] = _w ? nxtA[1] : curA[1]; \
        Q_LDA(Ay, b, 1); Q_MMA(0, Ax, Bc); Q_SCHED; \
        asm volatile("s_waitcnt vmcnt(8) lgkmcnt(0)" ::: "memory"); __builtin_amdgcn_s_barrier();      \
        Q_STAGE(b, _ao, _kb, _bb); \
        Q_LDA(Ax, ((b) + 1) & 3, 0); Q_LDB(Bn, ((b) + 1) & 3); Q_MMA(1, Ay, Bc); Q_SCHED; } while (0)
    Unit cur, nxt; int ui = 0;
    if (!pr.next(0, cur)) return;
    Acc acc;
#pragma unroll
    for (int a = 0; a < 2; ++a)
#pragma unroll
        for (int b = 0; b < 2; ++b)
#pragma unroll
            for (int m = 0; m < 4; ++m)
#pragma unroll
                for (int n = 0; n < 2; ++n) acc[a][b][m][n] = (f32x4){0.f, 0.f, 0.f, 0.f};
    bf16x8 Ax[4] = {}, Ay[4] = {}, Bx[2][2] = {}, By[2][2] = {};
    unsigned curA[2], nxtA[2];
    Q_FILL(cur, curA);
    unsigned cB = (unsigned)((const unsigned char*)pr.B(cur) - wsbase), nB = cB;
    Q_STAGE(0, curA, 0, cB); Q_STAGE(1, curA, 64, cB); Q_STAGE(2, curA, 128, cB); Q_STAGE(3, curA, 192, cB);
    asm volatile("s_waitcnt vmcnt(12)" ::: "memory"); __builtin_amdgcn_s_barrier();
    Q_LDA(Ax, 0, 0); Q_LDB(Bx, 0);
    for (;;) {
        const bool has_next = pr.next(ui + 1, nxt);
        nB = cB;
        if (has_next) { Q_FILL(nxt, nxtA); nB = (unsigned)((const unsigned char*)pr.B(nxt) - wsbase); } else { nxtA[0] = curA[0]; nxtA[1] = curA[1]; }
#pragma unroll 1
        for (int ks = 0; ks < nk; ks += 4) { Q_STEP(0, ks, Bx, By); Q_STEP(1, ks + 1, By, Bx); Q_STEP(2, ks + 2, Bx, By); Q_STEP(3, ks + 3, By, Bx); }
        pr.epi(acc, cur, wr, wc, fr, fq);
        if (!has_next) break;
#pragma unroll
        for (int a = 0; a < 2; ++a)
#pragma unroll
            for (int b = 0; b < 2; ++b)
#pragma unroll
                for (int m = 0; m < 4; ++m)
#pragma unroll
                    for (int n = 0; n < 2; ++n) acc[a][b][m][n] = (f32x4){0.f, 0.f, 0.f, 0.f};
        cur = nxt; cB = nB; curA[0] = nxtA[0]; curA[1] = nxtA[1]; ++ui;
    }
    asm volatile("s_waitcnt vmcnt(0) lgkmcnt(0)" ::: "memory");
    __builtin_amdgcn_s_barrier();
#undef Q_DMA
#undef Q_STAGE
#undef Q_LDA
#undef Q_LDB
#undef Q_MMA
#undef Q_FILL
#undef Q_SCHED
#undef Q_STEP
}
}

template <class P> __device__ __forceinline__ void ref_gemm_phase(const P& pr) {
    const int tid = threadIdx.x, wid = tid >> 6, lane = tid & 63;
    Unit u;
    Acc acc; bool keep = false;
    for (int i = 0; pr.next(i, u); ++i) { ref_gemm_thread(pr, u, tid, acc, keep); bool mid = false;
        if constexpr (P::HAS_MID) { mid = pr.is_mid(u); if (mid) pr.epi_mid(acc, u, wid >> 2, wid & 3, lane & 15, lane >> 4); else pr.epi(acc, u, wid >> 2, wid & 3, lane & 15, lane >> 4); } else pr.epi(acc, u, wid >> 2, wid & 3, lane & 15, lane >> 4);
        keep = mid; }
}
template <class P> __device__ __forceinline__ void run_gemm(LAS unsigned char* lds, const P& pr, const unsigned char* wsbase) {
#if USE_MFMA_GEMM
    if constexpr (P::ESZ == 2 && GEMM_PIPE == 2 && !P::HAS_MID) pg8::gemm_phase_pipe2<P>(lds, pr, wsbase); else if constexpr (P::ESZ == 2 && GEMM_PIPE == 1 && !P::HAS_MID) pg8::gemm_phase_pipe<P>(lds, pr, wsbase); else pg8::gemm_phase<P>(lds, pr, wsbase);
#endif
}
template <int WHICH> __global__ void __launch_bounds__(NTHREADS) ref_gemm_kernel(Params p) {
    const GridPos gp{(int)gridDim.x, (int)blockIdx.x};
    if constexpr (WHICH == 1) { const ProbInProj pr = mk_inproj(p, gp); ref_gemm_phase(pr); }
    if constexpr (WHICH == 2) { const ProbUpQ pr = mk_upq(p, gp); ref_gemm_phase(pr); }
    if constexpr (WHICH == 3) { const ProbUpKV pr = mk_upkv(p, gp); ref_gemm_phase(pr); }
    if constexpr (WHICH == 7) { const ProbBranch pr = mk_branch(p, gp); ref_gemm_phase(pr); }
    if constexpr (WHICH == 8) { const ProbOut pr = mk_out(p, gp); ref_gemm_phase(pr); }
    if constexpr (WHICH == 12) { const ProbMoe1 pr = mk_moe1(p, gp, 0); ref_gemm_phase(pr); }
    if constexpr (WHICH == 13) { const ProbMoe2 pr = mk_moe2(p, gp, 0); ref_gemm_phase(pr); }
    if constexpr (WHICH == 15) { const ProbMoe1 pr = mk_moe1(p, gp, 1); ref_gemm_phase(pr); }
    if constexpr (WHICH == 16) { const ProbMoe2 pr = mk_moe2(p, gp, 1); ref_gemm_phase(pr); }
}
template <int WHICH> __global__ void __launch_bounds__(256) ref_attn_kernel(Params p) {
    const long gthreads = (long)gridDim.x * 256, gtid = (long)blockIdx.x * 256 + threadIdx.x;
    const long per = gthreads / SEQ > 0 ? gthreads / SEQ : 1;
    for (long it = gtid; it < (long)NTOK * 8; it += gthreads) { const long bh = it / SEQ; const int pos = (int)(it % SEQ); const bool flip = ((bh / per) & 1) != 0; const long item = bh * SEQ + (flip ? SEQ - 1 - pos : pos);
        if constexpr (WHICH == 4) ref_attn_mla_item(p, item); else ref_attn_diff_item(p, item); }
}

namespace att {
typedef short bf16x8 __attribute__((ext_vector_type(8)));
typedef short s16x4 __attribute__((ext_vector_type(4)));
typedef float f32x16 __attribute__((ext_vector_type(16)));
#define ATT_SBAR() __builtin_amdgcn_sched_barrier(0)
__device__ __forceinline__ int crow(int r, int hi) { return (r & 3) + 8 * (r >> 2) + 4 * hi; }
__device__ __forceinline__ unsigned cvtpk(float lo, float hi) { unsigned r; asm volatile("v_cvt_pk_bf16_f32 %0, %1, %2" : "=v"(r) : "v"(lo), "v"(hi)); return r; }

__device__ __forceinline__ float max3f(float a, float b, float c) { float r; asm("v_max3_f32 %0, %1, %2, %3" : "=v"(r) : "v"(a), "v"(b), "v"(c)); return r; }
constexpr float THR2 = 8.f * 1.4426950408889634f;
__device__ __forceinline__ void rowmax_lo(const f32x16& p0, const f32x16& p1, float& a, float& b) {
    a = max3f(p0[0], p0[1], p1[0]); b = max3f(p0[2], p0[3], p1[1]); a = max3f(a, p1[2], p1[3]);
    a = max3f(a, p0[4], p0[5]); b = max3f(b, p0[6], p0[7]); a = max3f(a, p1[4], p1[5]); b = max3f(b, p1[6], p1[7]);
}
__device__ __forceinline__ float rowmax_hi(const f32x16& p0, const f32x16& p1, float a, float b) {
#pragma unroll
    for (int r = 8; r < 16; r += 4) { a = max3f(a, p0[r], p0[r + 1]); b = max3f(b, p0[r + 2], p0[r + 3]); a = max3f(a, p1[r], p1[r + 1]); b = max3f(b, p1[r + 2], p1[r + 3]); }
    float pmax = fmaxf(a, b);
    auto rr = __builtin_amdgcn_permlane32_swap(__float_as_uint(pmax), __float_as_uint(pmax), false, false);
    return fmaxf(__uint_as_float(rr[0]), __uint_as_float(rr[1]));
}
template <bool FORCE, bool NOEXP = false> __device__ __forceinline__ void partialSM_rest(f32x16& p0, f32x16& p1, float pmax, float& m_reg, float& alpha, f32x16& negm) {
    if (!FORCE && __builtin_expect(__all(pmax <= THR2), 1)) { alpha = 1.f; }
    else {
        const float d = FORCE ? pmax : fmaxf(pmax, 0.f);
        m_reg += d; alpha = FORCE ? 1.f : __builtin_amdgcn_exp2f(-d);
#pragma unroll
        for (int r = 0; r < 16; ++r) { p0[r] -= d; p1[r] -= d; negm[r] = -m_reg; }
    }
    if constexpr (!NOEXP) {
#pragma unroll
    for (int r = 0; r < 16; ++r) p0[r] = __builtin_amdgcn_exp2f(p0[r]); }
}
template <bool FORCE> __device__ __forceinline__ void partialSM(f32x16& p0, f32x16& p1, float& m_reg, float& alpha, f32x16& negm) {
    float a, b; rowmax_lo(p0, p1, a, b); const float pmax = rowmax_hi(p0, p1, a, b); partialSM_rest<FORCE>(p0, p1, pmax, m_reg, alpha, negm);
}
template <bool ONES, bool NOEXP = false> __device__ __forceinline__ void finishSM(f32x16& p0, f32x16& p1, float alpha, float& l_reg, bf16x8& pa0, bf16x8& pa1, bf16x8& pa2, bf16x8& pa3) {
    if constexpr (!NOEXP) {
#pragma unroll
    for (int r = 0; r < 16; ++r) p1[r] = __builtin_amdgcn_exp2f(p1[r]); }
    if constexpr (!ONES) { float ps = 0;
#pragma unroll
        for (int r = 0; r < 16; ++r) ps += p0[r];
#pragma unroll
        for (int r = 0; r < 16; ++r) ps += p1[r];
        auto rr = __builtin_amdgcn_permlane32_swap(__float_as_uint(ps), __float_as_uint(ps), false, false);
        ps = __uint_as_float(rr[0]) + __uint_as_float(rr[1]);
        l_reg = l_reg * alpha + ps; }
#define ATT_PK4(P, BASE, OUT) do { unsigned a0 = cvtpk(P[BASE + 0], P[BASE + 1]), a1 = cvtpk(P[BASE + 2], P[BASE + 3]);   \
    unsigned b0 = cvtpk(P[BASE + 4], P[BASE + 5]), b1 = cvtpk(P[BASE + 6], P[BASE + 7]);                              \
    auto r0 = __builtin_amdgcn_permlane32_swap(a0, b0, false, false); auto r1 = __builtin_amdgcn_permlane32_swap(a1, b1, false, false); \
    u32x4 w = {r0[0], r1[0], r0[1], r1[1]}; OUT = __builtin_bit_cast(bf16x8, w); } while (0)
    ATT_PK4(p0, 0, pa0); ATT_PK4(p0, 8, pa1); ATT_PK4(p1, 0, pa2); ATT_PK4(p1, 8, pa3);
#undef ATT_PK4
}
__device__ __forceinline__ void cmask(f32x16& p0, f32x16& p1, int jb, int qrel, int hi) {
    const int kb = 64 * jb + 4 * hi;
#pragma unroll
    for (int r = 0; r < 16; ++r) { const int kv = kb + (r & 3) + 8 * (r >> 2); if (kv > qrel) p0[r] = -INFINITY; if (kv + 32 > qrel) p1[r] = -INFINITY; }
}
template <int OFF> __device__ __forceinline__ s16x4 tr_read(int vb) {
    s16x4 r; asm volatile("ds_read_b64_tr_b16 %0, %1 offset:%2" : "=&v"(r) : "v"(vb), "i"(OFF) : "memory"); return r;
}
#define ATT_PV_BLOCK(NCBv, D0v, od, FILL) do { constexpr int KS = (NCBv) * 1024, HF = (NCBv) * 512, B = (D0v) * 512; \
    const s16x4 l0 = tr_read<B + 0 * KS>(vb), h0 = tr_read<B + 0 * KS + HF>(vb), l1 = tr_read<B + 1 * KS>(vb), h1 = tr_read<B + 1 * KS + HF>(vb); \
    const s16x4 l2 = tr_read<B + 2 * KS>(vb), h2 = tr_read<B + 2 * KS + HF>(vb), l3 = tr_read<B + 3 * KS>(vb), h3 = tr_read<B + 3 * KS + HF>(vb); \
    FILL; \
    asm volatile("s_waitcnt lgkmcnt(0)" ::: "memory"); ATT_SBAR(); \
    od = __builtin_amdgcn_mfma_f32_32x32x16_bf16(pa0, ATT_PK(l0, h0), od, 0, 0, 0); od = __builtin_amdgcn_mfma_f32_32x32x16_bf16(pa1, ATT_PK(l1, h1), od, 0, 0, 0); \
    od = __builtin_amdgcn_mfma_f32_32x32x16_bf16(pa2, ATT_PK(l2, h2), od, 0, 0, 0); od = __builtin_amdgcn_mfma_f32_32x32x16_bf16(pa3, ATT_PK(l3, h3), od, 0, 0, 0); } while (0)
#define ATT_PK(L, H) (bf16x8){L[0], L[1], L[2], L[3], H[0], H[1], H[2], H[3]}
template <int NCBV, int NB> __device__ __forceinline__ void pv_all(f32x16* o, int vb, bf16x8 pa0, bf16x8 pa1, bf16x8 pa2, bf16x8 pa3) {
    ATT_PV_BLOCK(NCBV, 0, o[0], (void)0); ATT_PV_BLOCK(NCBV, 1, o[1], (void)0);
    if constexpr (NB >= 3) ATT_PV_BLOCK(NCBV, 2, o[2], (void)0);
    if constexpr (NB >= 4) ATT_PV_BLOCK(NCBV, 3, o[3], (void)0);
    if constexpr (NB >= 5) ATT_PV_BLOCK(NCBV, 4, o[4], (void)0);
}
template <int NCBV, int NB> __device__ __forceinline__ float pv_all_max(f32x16* o, int vb, bf16x8 pa0, bf16x8 pa1, bf16x8 pa2, bf16x8 pa3, const f32x16& q0, const f32x16& q1) {
    float a, b, pmax;
    ATT_PV_BLOCK(NCBV, 0, o[0], rowmax_lo(q0, q1, a, b)); ATT_PV_BLOCK(NCBV, 1, o[1], pmax = rowmax_hi(q0, q1, a, b));
    if constexpr (NB >= 3) ATT_PV_BLOCK(NCBV, 2, o[2], (void)0);
    if constexpr (NB >= 4) ATT_PV_BLOCK(NCBV, 3, o[3], (void)0);
    if constexpr (NB >= 5) ATT_PV_BLOCK(NCBV, 4, o[4], (void)0);
    return pmax;
}
template <int DQK, int DV> struct Cfg {
    static constexpr bool ONES = false;
    static constexpr int KSTR = DQK * 2 + 16, SHM_K = 64 * KSTR, NCB = DV / 32, NCBV = NCB + (ONES ? 1 : 0), NB = NCBV, SHM_V = 64 * NCBV * 32 * 2;
    static constexpr int CK = DQK / 8, NKC = 64 * CK, NKL = (NKC + 511) / 512, CV = DV / 8, NVL = 64 * CV / 512;
    static constexpr int OFF_V = 0, OFF_K = 2 * SHM_V, OFF_WS = OFF_K + 2 * SHM_K, OFF_O = OFF_WS + NWAVES * 64 * 4, LDS_NEED = OFF_O + NWAVES * 32 * DV * 2;
    static_assert(LDS_NEED <= RING_BYTES && (OFF_WS % 16) == 0, "attention LDS map");
};
template <int NCB> __device__ __forceinline__ int v_st(int k, int c) { const int kk = (k & ~0xC) | ((k & 4) << 1) | ((k & 8) >> 1); return ((kk >> 3) * NCB + (c >> 5)) * 512 + ((kk & 7) * 32 + (c & 31)) * 2; }
__device__ __forceinline__ int v_rd_base(int lane) { return ((lane & 3) << 3) | (((lane >> 2) & 3) << 6) | (((lane >> 4) & 1) << 5) | (((lane >> 5) & 1) << 8); }

template <int DQK, int DV, int AVAR = 0, int MODE = 0, bool SMAX = false>
__device__ __forceinline__ void attn_unit(LAS unsigned char* lds, const bf16_t* __restrict__ Qb, int ldq, const bf16_t* __restrict__ Kh, int ldk, const bf16_t* __restrict__ Vh, int ldv,
                                          bf16_t* __restrict__ Ob, int ldo, int q0, float lam = 0.f, const float* __restrict__ subln = nullptr, float Mb = 0.f,
                                          const float* __restrict__ qgain = nullptr, const float* __restrict__ qtab = nullptr, const float* __restrict__ rqp = nullptr) {
    typedef Cfg<DQK, DV> C_; constexpr bool ONES = C_::ONES; constexpr int NCB = C_::NCB, NCBV = C_::NCBV, KSTR = C_::KSTR, SHM_K = C_::SHM_K, SHM_V = C_::SHM_V, CK = C_::CK, CV = C_::CV, NKL = C_::NKL, NVL = C_::NVL, ND = DQK / 16;
    int tid_ = threadIdx.x; asm volatile("" : "+v"(tid_));
    const int tid = tid_, wid = __builtin_amdgcn_readfirstlane(tid >> 6), lane = tid & 63, r32 = lane & 31, hi = lane >> 5;
    LAS unsigned char* V_lds = lds + C_::OFF_V; LAS unsigned char* K_lds = lds + C_::OFF_K;
    LAS float* ws = (LAS float*)(lds + C_::OFF_WS) + wid * 64; LAS float* al_l = ws + 32;
    LAS unsigned char* Ost = lds + C_::OFF_O + wid * (32 * DV * 2);
    float m_reg = 0.f, l_reg = 0.f; f32x16 o[NCBV]; f32x16 negm = f32x16{};
    if constexpr (SMAX) {
#pragma unroll
        for (int r = 0; r < 16; ++r) negm[r] = -Mb; }
#pragma unroll
    for (int d = 0; d < NCBV; ++d) o[d] = f32x16{};
    bf16x8 qr[ND];
    { const bf16_t* Qw = Qb + (size_t)(wid * 32 + r32) * ldq + hi * 8;
#pragma unroll
      for (int d0 = 0; d0 < ND; ++d0) qr[d0] = *(const bf16x8*)(Qw + d0 * 16); }
    { constexpr int NF = (DQK == 96) ? 16 : 32; constexpr float QS = (DQK == 96) ? QSCALE_MLA : QSCALE_DIFF;
      float x[ND][8]; float ss = 0.f;
#pragma unroll
      for (int d0 = 0; d0 < ND; ++d0) { const u32x4 w = __builtin_bit_cast(u32x4, qr[d0]); unpack8(w, x[d0]);
#pragma unroll
          for (int j = 0; j < 8; ++j) ss += x[d0][j] * x[d0][j]; }
      { auto rr = __builtin_amdgcn_permlane32_swap(__float_as_uint(ss), __float_as_uint(ss), false, false); ss = __uint_as_float(rr[0]) + __uint_as_float(rr[1]); }
      const float rq = rqp ? rqp[wid * 32 + r32] : 1.0f;
      const float rs = QS * rq / sqrtf(ss * rq * rq * (1.0f / DQK) + EPS);
#pragma unroll
      for (int d0 = 0; d0 < ND; ++d0)
#pragma unroll
          for (int j = 0; j < 8; ++j) x[d0][j] *= rs * qgain[d0 * 16 + 8 * hi + j];
      const float* tb = qtab + (size_t)(wid * 32 + r32) * (2 * NF);
      constexpr int DB = NF / 16;
#pragma unroll
      for (int d0 = ND - 2 * DB; d0 < ND - DB; ++d0)
#pragma unroll
          for (int j = 0; j < 8; ++j) { const int fi = (d0 - (ND - 2 * DB)) * 16 + 8 * hi + j; const float cs = tb[2 * fi], sn = tb[2 * fi + 1]; const float x1 = x[d0][j], x2 = x[d0 + DB][j];
              x[d0][j] = x1 * cs - x2 * sn; x[d0 + DB][j] = x2 * cs + x1 * sn; }
#pragma unroll
      for (int d0 = 0; d0 < ND; ++d0) qr[d0] = __builtin_bit_cast(bf16x8, pack8(x[d0])); }
    int krow[NKL], kcc[NKL], vrow[NVL], vcc[NVL];
#pragma unroll
    for (int i = 0; i < NKL; ++i) { const int id = (tid + 512 * i) % C_::NKC; krow[i] = id / CK; kcc[i] = id % CK; }
#pragma unroll
    for (int i = 0; i < NVL; ++i) { const int id = tid + 512 * i; vrow[i] = id / CV; vcc[i] = id % CV; }
    const int vb0 = (int)(uintptr_t)(V_lds) + v_rd_base(lane);
    bf16x8 sk[2][NKL], sv[2][NVL];
#define ATT_SLOAD(s, k0) do { _Pragma("unroll") for (int _i = 0; _i < NKL; ++_i) sk[s][_i] = *(const bf16x8*)(Kh + (size_t)((k0) + krow[_i]) * ldk + kcc[_i] * 8); \
        _Pragma("unroll") for (int _i = 0; _i < NVL; ++_i) sv[s][_i] = *(const bf16x8*)(Vh + (size_t)((k0) + vrow[_i]) * ldv + vcc[_i] * 8); } while (0)
#define ATT_SWRITE(b, s) do { _Pragma("unroll") for (int _i = 0; _i < NKL; ++_i) *(LAS bf16x8*)(K_lds + (b) * SHM_K + krow[_i] * KSTR + kcc[_i] * 16) = sk[s][_i]; \
        _Pragma("unroll") for (int _i = 0; _i < NVL; ++_i) *(LAS bf16x8*)(V_lds + (b) * SHM_V + v_st<NCBV>(vrow[_i], vcc[_i] * 8)) = sv[s][_i]; } while (0)
#define ATT_QKT(P0, P1, b) do { const LAS unsigned char* _kb = K_lds + (b) * SHM_K + r32 * KSTR + hi * 16; \
        { const bf16x8 _b0 = *(const LAS bf16x8*)(_kb), _b1 = *(const LAS bf16x8*)(_kb + 32 * KSTR); \
          P0 = __builtin_amdgcn_mfma_f32_32x32x16_bf16(_b0, qr[0], negm, 0, 0, 0); P1 = __builtin_amdgcn_mfma_f32_32x32x16_bf16(_b1, qr[0], negm, 0, 0, 0); } \
        _Pragma("unroll") for (int _d = 1; _d < ND; ++_d) { const bf16x8 _b0 = *(const LAS bf16x8*)(_kb + _d * 32), _b1 = *(const LAS bf16x8*)(_kb + 32 * KSTR + _d * 32); \
            P0 = __builtin_amdgcn_mfma_f32_32x32x16_bf16(_b0, qr[_d], P0, 0, 0, 0); P1 = __builtin_amdgcn_mfma_f32_32x32x16_bf16(_b1, qr[_d], P1, 0, 0, 0); } } while (0)
#define ATT_MASK(P0, P1, j) do { if ((j) >= NT - 4) cmask(P0, P1, (j) - (NT - 4), 32 * wid + r32, hi); } while (0)
#define ATT_RESC(a) do { if (__any((a) < 1.f)) { if (hi == 0) al_l[r32] = (a); asm volatile("s_waitcnt lgkmcnt(0)" ::: "memory"); \
        _Pragma("unroll") for (int _d = 0; _d < NCBV; ++_d) _Pragma("unroll") for (int _r = 0; _r < 16; ++_r) o[_d][_r] *= al_l[crow(_r, hi)]; } } while (0)
#define ATT_SYNC() do { if constexpr (AVAR != 1) __syncthreads(); } while (0)
    f32x16 pA0, pA1, pB0, pB1; float alA, alB; bf16x8 pa0, pa1, pa2, pa3;
    const int NT = (q0 + 256) / 64;
    __syncthreads();
    if constexpr (ONES) { const int bsel = tid >> 8, idx = tid & 255;
      *(LAS u32x4*)(V_lds + bsel * SHM_V + ((idx >> 5) * NCBV + NCB) * 512 + (idx & 31) * 16) = (u32x4){0x3f803f80u, 0x3f803f80u, 0x3f803f80u, 0x3f803f80u}; }
    ATT_SLOAD(0, 0); asm volatile("s_waitcnt vmcnt(0)" ::: "memory"); ATT_SWRITE(0, 0); __syncthreads();
    if constexpr (SMAX) {
#define ATT_EXP_LO(P0) do { _Pragma("unroll") for (int _r = 0; _r < 16; ++_r) P0[_r] = __builtin_amdgcn_exp2f(P0[_r]); } while (0)
        ATT_QKT(pA0, pA1, 0); ATT_MASK(pA0, pA1, 0); ATT_EXP_LO(pA0);
        ATT_SLOAD(1, 64); ATT_SLOAD(0, 128);
        ATT_SWRITE(1, 1); __syncthreads();
        for (int j = 1; j + 1 < NT; j += 2) {
            ATT_SBAR(); ATT_QKT(pB0, pB1, 1); ATT_MASK(pB0, pB1, j);
            finishSM<ONES>(pA0, pA1, 1.f, l_reg, pa0, pa1, pa2, pa3); ATT_SBAR();
            ATT_SLOAD(1, (j + 2) * 64); ATT_SBAR();
            pv_all<NCBV, NCBV>(o, vb0, pa0, pa1, pa2, pa3); ATT_EXP_LO(pB0);
            __syncthreads(); ATT_SWRITE(0, 0); __syncthreads();
            ATT_SBAR(); ATT_QKT(pA0, pA1, 0); ATT_MASK(pA0, pA1, j + 1);
            finishSM<ONES>(pB0, pB1, 1.f, l_reg, pa0, pa1, pa2, pa3); ATT_SBAR();
            ATT_SLOAD(0, (j + 3 < NT ? j + 3 : NT - 1) * 64);
            ATT_SBAR();
            pv_all<NCBV, NCBV>(o, vb0 + SHM_V, pa0, pa1, pa2, pa3); ATT_EXP_LO(pA0);
            __syncthreads(); ATT_SWRITE(1, 1); __syncthreads();
        }
        ATT_SBAR(); ATT_QKT(pB0, pB1, 1); ATT_MASK(pB0, pB1, NT - 1);
        finishSM<ONES>(pA0, pA1, 1.f, l_reg, pa0, pa1, pa2, pa3); ATT_SBAR();
        pv_all<NCBV, NCBV>(o, vb0, pa0, pa1, pa2, pa3); ATT_EXP_LO(pB0);
        __syncthreads();
        finishSM<ONES>(pB0, pB1, 1.f, l_reg, pa0, pa1, pa2, pa3); ATT_SBAR();
        pv_all<NCBV, NCBV>(o, vb0 + SHM_V, pa0, pa1, pa2, pa3);
#undef ATT_EXP_LO
    } else {
    ATT_QKT(pA0, pA1, 0); ATT_MASK(pA0, pA1, 0); partialSM<true>(pA0, pA1, m_reg, alA, negm);
    ATT_SLOAD(1, 64); ATT_SLOAD(0, 128);
    ATT_SWRITE(1, 1); __syncthreads();
    for (int j = 1; j + 1 < (AVAR == 6 ? 0 : NT); j += 2) {
        ATT_SBAR(); if constexpr (AVAR != 3) ATT_QKT(pB0, pB1, 1); else { pB0 = negm; pB1 = negm; } ATT_MASK(pB0, pB1, j);
        finishSM<ONES, AVAR == 2>(pA0, pA1, alA, l_reg, pa0, pa1, pa2, pa3); ATT_SBAR();
        if constexpr (AVAR != 5) ATT_SLOAD(1, (j + 2) * 64); ATT_SBAR();
        { float pm; if constexpr (AVAR != 4) pm = pv_all_max<NCBV, NCBV>(o, vb0, pa0, pa1, pa2, pa3, pB0, pB1); else { float a_, b_; rowmax_lo(pB0, pB1, a_, b_); pm = rowmax_hi(pB0, pB1, a_, b_); asm volatile("" :: "v"(pa0), "v"(pa1), "v"(pa2), "v"(pa3)); } partialSM_rest<false, AVAR == 2>(pB0, pB1, pm, m_reg, alB, negm); }
        ATT_SYNC(); if constexpr (AVAR != 5) ATT_SWRITE(0, 0);
        ATT_RESC(alB); ATT_SYNC();
        ATT_SBAR(); if constexpr (AVAR != 3) ATT_QKT(pA0, pA1, 0); else { pA0 = negm; pA1 = negm; } ATT_MASK(pA0, pA1, j + 1);
        finishSM<ONES, AVAR == 2>(pB0, pB1, alB, l_reg, pa0, pa1, pa2, pa3); ATT_SBAR();
        if constexpr (AVAR != 5) ATT_SLOAD(0, (j + 3 < NT ? j + 3 : NT - 1) * 64);
        ATT_SBAR();
        { float pm; if constexpr (AVAR != 4) pm = pv_all_max<NCBV, NCBV>(o, vb0 + SHM_V, pa0, pa1, pa2, pa3, pA0, pA1); else { float a_, b_; rowmax_lo(pA0, pA1, a_, b_); pm = rowmax_hi(pA0, pA1, a_, b_); asm volatile("" :: "v"(pa0), "v"(pa1), "v"(pa2), "v"(pa3)); } partialSM_rest<false, AVAR == 2>(pA0, pA1, pm, m_reg, alA, negm); }
        ATT_SYNC(); if constexpr (AVAR != 5) ATT_SWRITE(1, 1);
        ATT_RESC(alA); ATT_SYNC();
    }
    ATT_SBAR(); ATT_QKT(pB0, pB1, 1); ATT_MASK(pB0, pB1, NT - 1);
    finishSM<ONES>(pA0, pA1, alA, l_reg, pa0, pa1, pa2, pa3); ATT_SBAR();
    { const float pm = pv_all_max<NCBV, NCBV>(o, vb0, pa0, pa1, pa2, pa3, pB0, pB1); partialSM_rest<false>(pB0, pB1, pm, m_reg, alB, negm); }
    __syncthreads(); ATT_RESC(alB);
    finishSM<ONES>(pB0, pB1, alB, l_reg, pa0, pa1, pa2, pa3); ATT_SBAR();
    pv_all<NCBV, NCBV>(o, vb0 + SHM_V, pa0, pa1, pa2, pa3);
    }
    if constexpr (!ONES) { if (hi == 0) al_l[r32] = l_reg; asm volatile("s_waitcnt lgkmcnt(0)" ::: "memory"); }
    if constexpr (MODE == 2) {
#pragma unroll
        for (int r = 0; r < 16; ++r) { const int orow = crow(r, hi); float lsum; if constexpr (ONES) lsum = o[NCB][r]; else lsum = al_l[orow]; const float rl = __builtin_amdgcn_rcpf(lsum); float ss = 0.f;
#pragma unroll
            for (int d0 = 0; d0 < NCB; ++d0) { const float o1 = bf2f(*(const LAS bf16_t*)(Ost + (orow * DV + d0 * 32 + r32) * 2)); const float x = o1 - lam * bf2f(f2bf(o[d0][r] * rl)); o[d0][r] = x; ss += x * x; }
            ss += __shfl_xor(ss, 1); ss += __shfl_xor(ss, 2); ss += __shfl_xor(ss, 4); ss += __shfl_xor(ss, 8); ss += __shfl_xor(ss, 16);
            const float rs = (1.0f - LAMBDA_INIT) / sqrtf(ss * (1.0f / DV) + EPS);
#pragma unroll
            for (int d0 = 0; d0 < NCB; ++d0) *(LAS bf16_t*)(Ost + (orow * DV + d0 * 32 + r32) * 2) = f2bf(o[d0][r] * rs * subln[d0 * 32 + r32]); }
    } else {
#pragma unroll
        for (int r = 0; r < 16; ++r) { const int orow = crow(r, hi); float lsum; if constexpr (ONES) lsum = o[NCB][r]; else lsum = al_l[orow]; const float rl = __builtin_amdgcn_rcpf(lsum);
#pragma unroll
            for (int d0 = 0; d0 < NCB; ++d0) *(LAS bf16_t*)(Ost + (orow * DV + d0 * 32 + r32) * 2) = f2bf(o[d0][r] * rl); }
    }
    asm volatile("s_waitcnt lgkmcnt(0)" ::: "memory");
    if constexpr (MODE != 1) {
#pragma unroll
    for (int i = 0; i < CV / 2; ++i) { const int id = lane + 64 * i, row = id / CV, cc = id % CV;
        const u32x4 w = *(const LAS u32x4*)(Ost + (row * DV + cc * 8) * 2);
        *(u32x4*)(Ob + (size_t)(wid * 32 + row) * ldo + cc * 8) = w; }
    }
#undef ATT_SYNC
#undef ATT_SLOAD
#undef ATT_SWRITE
#undef ATT_QKT
#undef ATT_MASK
#undef ATT_RESC
}
__device__ __forceinline__ bool attn_next(const GridPos& g, int i, int& bh, int& qb) {
    constexpr int NBH = BATCH * 8, NQB = SEQ / 256;
    if (g.G % 8 == 0 && g.G / 8 == NQB && NBH % 8 == 0) { if (i >= NBH / 8) return false; const int xcd = g.c % 8, r = g.c / 8; bh = xcd * (NBH / 8) + i; qb = ((i >> 1) & 1) ? NQB - 1 - r : r; return true; }
    const long u = (long)(i >> 1) * g.G + g.c; if (u >= (long)NBH / 2 * NQB) return false; bh = (int)(u / NQB) * 2 + (i & 1); qb = (int)(u % NQB); return true;
}
}
constexpr float SBOUND_MAX = 40.f;
__device__ __forceinline__ void attn_mla_phase(LAS unsigned char* lds, const Params& p, const GridPos& g) {
    int bh, qb; const float Mb = wsp<float>(p, WS_MISC + MS_SBOUND)[0];
#define MLA_UNIT(SM) { const int b = bh >> 3, h = bh & 7; const size_t tok0 = (size_t)b * SEQ, row0 = tok0 + (size_t)qb * 256; \
        att::attn_unit<96, 64, 0, 0, SM>(lds, wsp<bf16_t>(p, WS_QA) + row0 * QA_W + h * 96, QA_W, wsp<bf16_t>(p, WS_KV) + tok0 * KV_W + h * 160, KV_W, wsp<bf16_t>(p, WS_KV) + tok0 * KV_W + h * 160 + 96, KV_W, \
                               wsp<bf16_t>(p, WS_OA) + row0 * 512 + h * 64, 512, qb * 256, 0.f, nullptr, Mb, p.mla_q_norm, wsp<float>(p, WS_ROPE) + (size_t)(qb * 256) * 32, wsp<float>(p, WS_MISC + MS_RQ) + row0); }
    if (Mb < SBOUND_MAX) { for (int i = 0; att::attn_next(g, i, bh, qb); ++i) MLA_UNIT(true) }
    else { for (int i = 0; att::attn_next(g, i, bh, qb); ++i) MLA_UNIT(false) }
#undef MLA_UNIT
}
__device__ __forceinline__ void attn_diff_phase(LAS unsigned char* lds, const Params& p, const GridPos& g) {
    int bh, qb; const bf16_t* proj = wsp<bf16_t>(p, WS_PROJ); const float lam = *wsp<float>(p, WS_MISC + MS_LAMBDA); const float Mb = wsp<float>(p, WS_MISC + MS_SBOUND)[1];
#define DIFF_PAIR(SM) { const int b = bh >> 3, h = bh & 7; const size_t tok0 = (size_t)b * SEQ, row0 = tok0 + (size_t)qb * 256; \
        const bf16_t* vp = proj + tok0 * PROJ_W + PC_DV + (h >> 1) * 128; bf16_t* ob = wsp<bf16_t>(p, WS_OB) + row0 * 512 + (h >> 1) * 128; \
        att::attn_unit<64, 128, 0, 1, SM>(lds, proj + row0 * PROJ_W + PC_DQ + h * 64, PROJ_W, proj + tok0 * PROJ_W + PC_DK + h * 64, PROJ_W, vp, PROJ_W, ob, 512, qb * 256, 0.f, nullptr, Mb, p.diff_q_norm, wsp<float>(p, WS_ROPE) + (size_t)SEQ * 32 + (size_t)(qb * 256) * 64, nullptr); \
        att::attn_unit<64, 128, 0, 2, SM>(lds, proj + row0 * PROJ_W + PC_DQ + (h + 1) * 64, PROJ_W, proj + tok0 * PROJ_W + PC_DK + (h + 1) * 64, PROJ_W, vp, PROJ_W, ob, 512, qb * 256, lam, p.subln, Mb, p.diff_q_norm, wsp<float>(p, WS_ROPE) + (size_t)SEQ * 32 + (size_t)(qb * 256) * 64, nullptr); }
    if (Mb < SBOUND_MAX) { for (int i = 0; att::attn_next(g, i, bh, qb); i += 2) DIFF_PAIR(true) }
    else { for (int i = 0; att::attn_next(g, i, bh, qb); i += 2) DIFF_PAIR(false) }
#undef DIFF_PAIR
}

__device__ __forceinline__ float wave_sum(float v) {
#pragma unroll
    for (int o = 1; o < 64; o <<= 1) v += __shfl_xor(v, o);
    return v;
}
__device__ __forceinline__ void xn_rows4_wave(const Params& p, int token0, int lane) {
    const f32x4* gr = (const f32x4*)p.attn_norm + lane;
    f32x4 v[4][4]; float s[4];
#pragma unroll
    for (int t = 0; t < 4; ++t) { const f32x4* xr = (const f32x4*)(p.x + (size_t)(token0 + t) * 1024) + lane; s[t] = 0.f;
#pragma unroll
        for (int j = 0; j < 4; ++j) v[t][j] = __builtin_nontemporal_load(xr + 64 * j); }
#pragma unroll
    for (int t = 0; t < 4; ++t)
#pragma unroll
        for (int j = 0; j < 4; ++j) s[t] += (v[t][j].x * v[t][j].x + v[t][j].y * v[t][j].y) + (v[t][j].z * v[t][j].z + v[t][j].w * v[t][j].w);
#pragma unroll
    for (int o = 1; o < 64; o <<= 1) {
#pragma unroll
        for (int t = 0; t < 4; ++t) s[t] += __shfl_xor(s[t], o); }
    f32x4 g[4];
#pragma unroll
    for (int j = 0; j < 4; ++j) g[j] = gr[64 * j];
#pragma unroll
    for (int t = 0; t < 4; ++t) { const float rs = 1.0f / sqrtf(s[t] * (1.f / 1024) + EPS);
        unsigned long long* o8 = (unsigned long long*)(wsp<bf16_t>(p, WS_XN) + (size_t)(token0 + t) * 1024) + lane;
#pragma unroll
        for (int j = 0; j < 4; ++j) o8[64 * j] = (unsigned long long)pk2(v[t][j].x * rs * g[j].x, v[t][j].y * rs * g[j].y) | ((unsigned long long)pk2(v[t][j].z * rs * g[j].z, v[t][j].w * rs * g[j].w) << 32);
#if FP8_GATES
        { unsigned* q8 = (unsigned*)(wsp<unsigned char>(p, WS_XN8) + (size_t)(token0 + t) * 1024) + lane; const float s8 = rs * (float)(1 << EXP_T);
#pragma unroll
          for (int j = 0; j < 4; ++j) q8[64 * j] = pk4_e4m3(v[t][j].x * s8 * g[j].x, v[t][j].y * s8 * g[j].y, v[t][j].z * s8 * g[j].z, v[t][j].w * s8 * g[j].w); }
#endif
    }
}
__device__ __forceinline__ void ffn_rstd_wave(const Params& p, int token, int lane) {
    const f32x4* xr = (const f32x4*)(p.out + (size_t)token * 1024) + lane; float s = 0.f;
#pragma unroll
    for (int j = 0; j < 4; ++j) { const f32x4 v = xr[64 * j]; s += (v.x * v.x + v.y * v.y) + (v.z * v.z + v.w * v.w); }
    const float rs = 1.0f / sqrtf(wave_sum(s) * (1.f / 1024) + EPS);
    if (lane == 0) wsp<float>(p, WS_MISC + MS_RSTD)[token] = rs;
}

__device__ __forceinline__ void transpose_tile(const float* W, int N, int k0, int n0, bf16_t* WT, int K, int d0, const float* gain, LAS float* scr, int lane) {
#pragma unroll 16
    for (int i = 0; i < 32; ++i) { const int kk = 2 * i + (lane >> 5); float v = (n0 >= 0) ? W[(size_t)(k0 + kk) * N + n0 + (lane & 31)] : 0.f; if (gain) v *= gain[k0 + kk]; scr[kk * 33 + (lane & 31)] = v; }
    asm volatile("s_waitcnt lgkmcnt(0)" ::: "memory");
    const int cch = lane & 7;
#pragma unroll
    for (int j = 0; j < 4; ++j) { const int n = (lane >> 3) + 8 * j; const LAS float* s = scr + (8 * cch) * 33 + n;
        u32x4 o; o.x = pk2(s[0 * 33], s[1 * 33]); o.y = pk2(s[2 * 33], s[3 * 33]); o.z = pk2(s[4 * 33], s[5 * 33]); o.w = pk2(s[6 * 33], s[7 * 33]);
        *(u32x4*)(WT + (size_t)(d0 + n) * K + k0 + 8 * cch) = o; }
    asm volatile("s_waitcnt lgkmcnt(0)" ::: "memory");
}
__device__ __forceinline__ void transpose_tile8(const float* W, int N, int k0, int n0, unsigned char* WT, int K, int d0, float mul, LAS float* scr, int lane) {
#pragma unroll 16
    for (int i = 0; i < 32; ++i) { const int kk = 2 * i + (lane >> 5); scr[kk * 33 + (lane & 31)] = W[(size_t)(k0 + kk) * N + n0 + (lane & 31)] * mul; }
    asm volatile("s_waitcnt lgkmcnt(0)" ::: "memory");
    const int cch = lane & 7;
#pragma unroll
    for (int j = 0; j < 4; ++j) { const int n = (lane >> 3) + 8 * j; const LAS float* s = scr + (8 * cch) * 33 + n;
        typedef unsigned u2_t __attribute__((ext_vector_type(2))); u2_t o; o.x = pk4_e4m3(s[0 * 33], s[1 * 33], s[2 * 33], s[3 * 33]); o.y = pk4_e4m3(s[4 * 33], s[5 * 33], s[6 * 33], s[7 * 33]);
        *(u2_t*)(WT + (size_t)(d0 + n) * K + k0 + 8 * cch) = o; }
    asm volatile("s_waitcnt lgkmcnt(0)" ::: "memory");
}
constexpr int TI_WIN = 16 * (PROJ_W / 32), TI_WUQ = 12 * 24, TI_WUKV = 4 * 32, TI_WB = 8 * 32, TI_WOUT = 16 * 32, TI_SMALL = TI_WIN + TI_WUQ + TI_WUKV + 2 * TI_WB + TI_WOUT;
__device__ __forceinline__ void smallw_tile(const Params& p, int it, LAS float* scr, int lane) {
    if (it < TI_WIN) { const int kb = it / (PROJ_W / 32), nb = it % (PROJ_W / 32);
        if (FP8_GATES && nb * 32 >= FP8_C0) transpose_tile8(p.w_in, 4640, kb * 64, win_src_col(nb * 32), wsp<unsigned char>(p, WS_WIN8), 1024, nb * 32 - FP8_C0, (float)(1 << EXP_W), scr, lane);
        else transpose_tile(p.w_in, 4640, kb * 64, win_src_col(nb * 32), wsp<bf16_t>(p, WS_WIN), 1024, nb * 32, nullptr, scr, lane); return; } it -= TI_WIN;
    if (it < TI_WUQ) { const int kb = it / 24, nb = it % 24; transpose_tile(p.w_uq, 768, kb * 64, nb * 32, wsp<bf16_t>(p, WS_WUQ), 768, nb * 32, p.q_lat_norm, scr, lane); return; } it -= TI_WUQ;
    if (it < TI_WUKV) { const int kb = it / 32, nb = it % 32; transpose_tile(p.w_ukv, 1024, kb * 64, nb * 32, wsp<bf16_t>(p, WS_WUKV), 256, nb * 32, p.kv_lat_norm, scr, lane); return; } it -= TI_WUKV;
    if (it < TI_WB) { const int kb = it / 32, nb = it % 32; transpose_tile(p.w_ba, 1024, kb * 64, nb * 32, wsp<bf16_t>(p, WS_WBA), 512, nb * 32, nullptr, scr, lane); return; } it -= TI_WB;
    if (it < TI_WB) { const int kb = it / 32, nb = it % 32; transpose_tile(p.w_bb, 1024, kb * 64, nb * 32, wsp<bf16_t>(p, WS_WBB), 512, nb * 32, nullptr, scr, lane); return; } it -= TI_WB;
    { const int kb = it / 32, nb = it % 32; transpose_tile(p.w_out, 1024, kb * 64, nb * 32, wsp<bf16_t>(p, WS_WOUT), 1024, nb * 32, nullptr, scr, lane); }
}
__device__ __forceinline__ void transpose_tile8x(const float* W, int N, int k0, int n0, unsigned char* WT, int K, int d0, float mul, int lane) {
    const int q = lane & 15, g = lane >> 4; const float* src = W + (size_t)(k0 + 16 * g) * N + n0 + 4 * q; f32x4 v[16];
#pragma unroll
    for (int i = 0; i < 16; ++i) v[i] = __builtin_nontemporal_load((const f32x4*)(src + (size_t)i * N));
#pragma unroll
    for (int j = 0; j < 4; ++j) { u32x4 o;
#pragma unroll
        for (int w = 0; w < 4; ++w) o[w] = pk4_e4m3(v[4 * w][j] * mul, v[4 * w + 1][j] * mul, v[4 * w + 2][j] * mul, v[4 * w + 3][j] * mul);
        *(u32x4*)(WT + (size_t)(d0 + 4 * q + j) * K + k0 + 16 * g) = o; }
}
constexpr int TI_W1 = NE * 16 * 32, TI_W2 = NE * 16 * 16, TI_MOEW = TI_W1 + TI_W2;
__device__ __forceinline__ void moew_tile(const Params& p, int it, LAS float* scr, int lane) {
    if (it < TI_W1) { const int e = it / (16 * 32), r = it % (16 * 32), nb = r / 16, kb = r % 16;
        transpose_tile8x(p.w1 + (size_t)e * 1024 * 2048, 2048, kb * 64, w1_src_col(nb * 64), wsp<unsigned char>(p, WS_W1) + (size_t)e * 2048 * 1024, 1024, nb * 64, (float)(1 << EXP_W), lane); return; }
    it -= TI_W1;
    { const int e = it / (16 * 16), r = it % (16 * 16), nb = r / 16, kb = r % 16;
        transpose_tile8x(p.w2 + (size_t)e * 1024 * 1024, 1024, kb * 64, nb * 64, wsp<unsigned char>(p, WS_W2) + (size_t)e * 1024 * 1024, 1024, nb * 64, (float)(1 << EXP_W), lane); }
}
__device__ __forceinline__ void router_wave(const Params& p, int tok0, int lane) {
    typedef short bf16x8 __attribute__((ext_vector_type(8))); typedef float f32x16 __attribute__((ext_vector_type(16)));
    const int r32 = lane & 31, hi = lane >> 5;
    const float* hrow = p.out + (size_t)(tok0 + r32) * 1024 + 8 * hi;
    const u32x4* wh = wsp<u32x4>(p, WS_WRH) + lane; const u32x4* wl = wsp<u32x4>(p, WS_WRL) + lane;
    f32x16 acc = f32x16{}; float ss = 0.f;
#pragma unroll 4
    for (int s = 0; s < 64; ++s) {
        const f32x4 a0 = *(const f32x4*)(hrow + 16 * s), a1 = *(const f32x4*)(hrow + 16 * s + 4);
        float a[8] = {a0[0], a0[1], a0[2], a0[3], a1[0], a1[1], a1[2], a1[3]}, ah[8], al[8];
#pragma unroll
        for (int j = 0; j < 8; ++j) { ss += a[j] * a[j]; ah[j] = bf2f(f2bf(a[j])); al[j] = a[j] - ah[j]; }
        const bf16x8 fah = __builtin_bit_cast(bf16x8, pack8(ah)), fal = __builtin_bit_cast(bf16x8, pack8(al));
        const bf16x8 fwh = __builtin_bit_cast(bf16x8, wh[64 * s]), fwl = __builtin_bit_cast(bf16x8, wl[64 * s]);
        acc = __builtin_amdgcn_mfma_f32_32x32x16_bf16(fah, fwh, acc, 0, 0, 0);
        acc = __builtin_amdgcn_mfma_f32_32x32x16_bf16(fal, fwh, acc, 0, 0, 0);
        acc = __builtin_amdgcn_mfma_f32_32x32x16_bf16(fah, fwl, acc, 0, 0, 0);
    }
    ss += __shfl_xor(ss, 32);
    const float rs = 1.0f / sqrtf(ss * (1.f / 1024) + EPS);
    if (hi == 0) wsp<float>(p, WS_MISC + MS_RSTD)[tok0 + r32] = rs;
    const float be = p.b_router[r32]; float* lg = wsp<float>(p, WS_LOGIT);
#pragma unroll
    for (int r = 0; r < 16; ++r) { const int row = (r & 3) + 8 * (r >> 2) + 4 * hi; const float rr = __shfl(rs, row); lg[(size_t)(tok0 + row) * NE + r32] = acc[r] * rr + be; }
}
__device__ __forceinline__ void router_wave2(const Params& p, int tok0, int wave, int lane, LAS float* lbuf, LAS int* cnts, int (&idx)[4], int (&rank)[4]) {
    typedef short bf16x8 __attribute__((ext_vector_type(8))); typedef float f32x16 __attribute__((ext_vector_type(16)));
    const int r32 = lane & 31, hi = lane >> 5;
    const bf16_t* hrow = wsp<bf16_t>(p, WS_HB) + (size_t)(tok0 + r32) * 1024 + 8 * hi;
    const u32x4* wh = wsp<u32x4>(p, WS_WRH) + lane; const u32x4* wl = wsp<u32x4>(p, WS_WRL) + lane;
    f32x16 acc = f32x16{}; float ss = 0.f;
    LAS unsigned char* tb = (LAS unsigned char*)lbuf; const float* gn = p.ffn_norm + 8 * hi; unsigned char* Tw = wsp<unsigned char>(p, WS_T) + (size_t)tok0 * 1024;
    for (int s8 = 0; s8 < 8; ++s8) {
#pragma unroll 4
        for (int si = 0; si < 8; ++si) { const int s = s8 * 8 + si;
            const u32x4 aw = *(const u32x4*)(hrow + 16 * s);
            const f32x4 g0 = *(const f32x4*)(gn + 16 * s), g1 = *(const f32x4*)(gn + 16 * s + 4);
            float a[8]; unpack8(aw, a);
#pragma unroll
            for (int j = 0; j < 8; ++j) ss += a[j] * a[j];
            const bf16x8 fah = __builtin_bit_cast(bf16x8, aw);
            const bf16x8 fwh = __builtin_bit_cast(bf16x8, wh[64 * s]), fwl = __builtin_bit_cast(bf16x8, wl[64 * s]);
            acc = __builtin_amdgcn_mfma_f32_32x32x16_bf16(fah, fwh, acc, 0, 0, 0);
            acc = __builtin_amdgcn_mfma_f32_32x32x16_bf16(fah, fwl, acc, 0, 0, 0);
            constexpr float TS = (float)(1 << EXP_T); typedef unsigned u2_t __attribute__((ext_vector_type(2)));
#define T8C(x) __builtin_amdgcn_fmed3f((x), -448.0f, 448.0f)
            u2_t w; w.x = pk4_e4m3(T8C(a[0] * g0[0] * TS), T8C(a[1] * g0[1] * TS), T8C(a[2] * g0[2] * TS), T8C(a[3] * g0[3] * TS)); w.y = pk4_e4m3(T8C(a[4] * g1[0] * TS), T8C(a[5] * g1[1] * TS), T8C(a[6] * g1[2] * TS), T8C(a[7] * g1[3] * TS));
#undef T8C
            *(LAS u2_t*)(tb + r32 * 144 + si * 16 + hi * 8) = w; }
        asm volatile("s_waitcnt lgkmcnt(0)" ::: "memory");
#pragma unroll
        for (int i = 0; i < 4; ++i) { const int q = lane + 64 * i, row = q >> 3, part = q & 7;
            const u32x4 w = *(const LAS u32x4*)(tb + row * 144 + part * 16);
            *(u32x4*)(Tw + (size_t)row * 1024 + s8 * 128 + part * 16) = w; }
        asm volatile("s_waitcnt lgkmcnt(0)" ::: "memory");
    }
    ss += __shfl_xor(ss, 32);
    const float rs = 1.0f / sqrtf(ss * (1.f / 1024) + EPS);
    if (hi == 0) wsp<float>(p, WS_MISC + MS_RSTD)[tok0 + r32] = rs;
    const float be = p.b_router[r32];
#pragma unroll
    for (int r = 0; r < 16; ++r) { const int row = (r & 3) + 8 * (r >> 2) + 4 * hi; const float rr = __shfl(rs, row); lbuf[row * 33 + r32] = acc[r] * rr + be; }
    asm volatile("s_waitcnt lgkmcnt(0)" ::: "memory");
    float v[NE];
#pragma unroll
    for (int e = 0; e < NE; ++e) v[e] = lbuf[r32 * 33 + e];
    float val[4];
#pragma unroll
    for (int k = 0; k < 4; ++k) { int bi = 0; float bv = -INFINITY;
#pragma unroll
        for (int e = 0; e < NE; ++e) { const bool taken = (k > 0 && idx[0] == e) || (k > 1 && idx[1] == e) || (k > 2 && idx[2] == e); if (!taken && v[e] > bv) { bv = v[e]; bi = e; } }
        idx[k] = bi; val[k] = bv; }
    const float m = val[0]; float ex[4], sum = 0.f;
#pragma unroll
    for (int k = 0; k < 4; ++k) { ex[k] = expf(val[k] - m); sum += ex[k]; }
    if (hi == 0) { typedef int i32x4 __attribute__((ext_vector_type(4)));
        *(i32x4*)(wsp<int>(p, WS_TOPI) + (size_t)(tok0 + r32) * 4) = (i32x4){idx[0], idx[1], idx[2], idx[3]};
        *(f32x4*)(wsp<float>(p, WS_TOPW) + (size_t)(tok0 + r32) * 4) = (f32x4){ex[0] / sum, ex[1] / sum, ex[2] / sum, ex[3] / sum}; }
    const unsigned below = (1u << r32) - 1u; int mycnt = 0;
#pragma unroll
    for (int k = 0; k < 4; ++k) rank[k] = 0;
#pragma unroll 1
    for (int e = 0; e < NE; ++e) {
        const unsigned b0 = (unsigned)__ballot(idx[0] == e), b1 = (unsigned)__ballot(idx[1] == e), b2 = (unsigned)__ballot(idx[2] == e), b3 = (unsigned)__ballot(idx[3] == e);
        const int ce = __builtin_popcount(b0) + __builtin_popcount(b1) + __builtin_popcount(b2) + __builtin_popcount(b3);
        const int lo = __builtin_popcount(b0 & below) + __builtin_popcount(b1 & below) + __builtin_popcount(b2 & below) + __builtin_popcount(b3 & below);
#pragma unroll
        for (int k = 0; k < 4; ++k) if (idx[k] == e) rank[k] = lo;
        if (r32 == e) mycnt = ce; }
    if (hi == 0) cnts[wave * 32 + r32] = mycnt;
}
__device__ __forceinline__ void router_finish(const Params& p, int tok0, int chunk, int wave, int lane, const LAS int* cnts, const int (&idx)[4], int (&rank)[4]) {
    if (lane < 32) {
        for (int w = 0; w < wave; ++w) {
#pragma unroll
            for (int k = 0; k < 4; ++k) rank[k] += cnts[w * 32 + idx[k]]; }
        typedef int i32x4 __attribute__((ext_vector_type(4)));
        *(i32x4*)(wsp<int>(p, WS_SLOT) + (size_t)(tok0 + lane) * 4) = (i32x4){rank[0], rank[1], rank[2], rank[3]};
        if (wave == 0) { int s = 0;
#pragma unroll
            for (int w = 0; w < NWAVES; ++w) s += cnts[w * 32 + lane];
            wsp<int>(p, WS_MISC + MS_CHUNKCNT)[chunk * 32 + lane] = s; } }
}
__device__ __forceinline__ void post_rstd_wave(const Params& p, int token, int lane, float& rq, float& rkv) {
    const bf16_t* proj = wsp<bf16_t>(p, WS_PROJ) + (size_t)token * PROJ_W; float v[8]; float sq = 0.f, sk = 0.f;
    load8(proj + PC_QLAT + lane * 8, v);
#pragma unroll
    for (int j = 0; j < 8; ++j) sq += v[j] * v[j];
    if (lane < 32) { load8(proj + PC_QLAT + 512 + lane * 8, v);
#pragma unroll
        for (int j = 0; j < 8; ++j) sq += v[j] * v[j];
        load8(proj + PC_KVLAT + lane * 8, v);
#pragma unroll
        for (int j = 0; j < 8; ++j) sk += v[j] * v[j]; }
    rq = 1.0f / sqrtf(wave_sum(sq) * (1.f / QLORA) + EPS); rkv = 1.0f / sqrtf(wave_sum(sk) * (1.f / KVLORA) + EPS);
}

__device__ __forceinline__ void post_tokens2_wave(const Params& p, int tokA, int lane, LAS float* bufA) {
    const int hd = lane >> 3, part = lane & 7;
    bf16_t* proj[2]; bf16_t* kvr[2]; const float* tab_mla[2]; const float* tab_diff[2]; LAS float* buf[2] = {bufA, bufA + 768};
#pragma unroll
    for (int t = 0; t < 2; ++t) { const int token = tokA + t, pos = token % SEQ; proj[t] = wsp<bf16_t>(p, WS_PROJ) + (size_t)token * PROJ_W; kvr[t] = wsp<bf16_t>(p, WS_KV) + (size_t)token * KV_W;
        tab_mla[t] = wsp<float>(p, WS_ROPE) + (size_t)pos * 32; tab_diff[t] = wsp<float>(p, WS_ROPE) + (size_t)SEQ * 32 + (size_t)pos * 64; }
    u32x4 wkn[2], wkp[2], wdk[2]; float ssq[2];
#pragma unroll
    for (int t = 0; t < 2; ++t) { ssq[t] = wsp<float>(p, WS_SSP)[(size_t)(tokA + t) * 16 + (lane & 15)];
        wkn[t] = *(const u32x4*)(kvr[t] + hd * 160 + part * 8); wkp[t] = *(const u32x4*)(proj[t] + PC_KPE + (part & 3) * 8);
        wdk[t] = *(const u32x4*)(proj[t] + PC_DK + hd * 64 + part * 8); }
    float rq[2];
#pragma unroll
    for (int t = 0; t < 2; ++t) { float sq = (lane & 15) < 12 ? ssq[t] : 0.f; sq += __shfl_xor(sq, 1); sq += __shfl_xor(sq, 2); sq += __shfl_xor(sq, 4); sq += __shfl_xor(sq, 8);
        rq[t] = 1.0f / sqrtf(sq * (1.f / QLORA) + EPS); if (lane == 0) wsp<float>(p, WS_MISC + MS_RQ)[tokA + t] = rq[t]; }
#pragma unroll
    for (int t = 0; t < 2; ++t) { float v[8]; unpack8(wkn[t], v);
#pragma unroll
        for (int j = 0; j < 8; ++j) buf[t][(hd * 12 + part) * 8 + j] = v[j];
        if (part < 4) { unpack8(wkp[t], v);
#pragma unroll
            for (int j = 0; j < 8; ++j) buf[t][(hd * 12 + 8 + part) * 8 + j] = v[j]; } }
    asm volatile("s_waitcnt lgkmcnt(0)" ::: "memory");
    float rsk[2];
#pragma unroll
    for (int t = 0; t < 2; ++t) { float ss = 0.f;
#pragma unroll
        for (int j = 0; j < 12; ++j) { const float x = buf[t][hd * 96 + part * 12 + j]; ss += x * x; }
        rsk[t] = ss; }
#pragma unroll
    for (int o = 1; o < 8; o <<= 1) { rsk[0] += __shfl_xor(rsk[0], o); rsk[1] += __shfl_xor(rsk[1], o); }
#pragma unroll
    for (int t = 0; t < 2; ++t) rsk[t] = 1.0f / sqrtf(rsk[t] * (1.0f / 96) + EPS);
    const float* gain = p.mla_k_norm;
#pragma unroll
    for (int i = 0; i < 2; ++i) { const int c = lane + 64 * i; const int cv = c < 96 ? c : 0; const int hc = cv / 12, cc = cv % 12;
#pragma unroll
        for (int t = 0; t < 2; ++t) { const float rs = __shfl(rsk[t], hc * 8); float o[8];
            if (cc < 8) {
#pragma unroll
                for (int j = 0; j < 8; ++j) o[j] = buf[t][cv * 8 + j] * rs * gain[cc * 8 + j];
            } else { const bool first = cc < 10; const int ccp = first ? cc + 2 : cc - 2;
#pragma unroll
                for (int j = 0; j < 8; ++j) { const float a = buf[t][cv * 8 + j] * rs * gain[cc * 8 + j], b = buf[t][(hc * 12 + ccp) * 8 + j] * rs * gain[ccp * 8 + j];
                    const int fi = (cc & 1) * 8 + j; const float cs = tab_mla[t][2 * fi], sn = tab_mla[t][2 * fi + 1]; o[j] = first ? a * cs - b * sn : a * cs + b * sn; } }
            if (c < 96) store8(kvr[t] + hc * 160 + cc * 8, o); } }
    float dkv[2][8], dss[2];
#pragma unroll
    for (int t = 0; t < 2; ++t) { unpack8(wdk[t], dkv[t]); float ss = 0.f;
#pragma unroll
        for (int j = 0; j < 8; ++j) ss += dkv[t][j] * dkv[t][j];
        dss[t] = ss; }
#pragma unroll
    for (int o = 1; o < 8; o <<= 1) { dss[0] += __shfl_xor(dss[0], o); dss[1] += __shfl_xor(dss[1], o); }
    { const float* dg = p.diff_k_norm; const bool first = part < 4; const int pp = part ^ 4;
#pragma unroll
      for (int t = 0; t < 2; ++t) { const float rs = 1.0f / sqrtf(dss[t] * (1.0f / 64) + EPS); float o[8];
#pragma unroll
          for (int j = 0; j < 8; ++j) { const float a = dkv[t][j] * rs * dg[part * 8 + j]; const float b = __shfl_xor(dkv[t][j], 4) * rs * dg[pp * 8 + j];
              const int fi = (part & 3) * 8 + j; const float cs = tab_diff[t][2 * fi], sn = tab_diff[t][2 * fi + 1]; o[j] = first ? a * cs - b * sn : a * cs + b * sn; }
          store8(proj[t] + PC_DK + hd * 64 + part * 8, o); } }
    asm volatile("s_waitcnt lgkmcnt(0)" ::: "memory");
}

constexpr int N_PHASES = 19;
__global__ void __launch_bounds__(NTHREADS, 2) fwd(Params p) {
    extern __shared__ __attribute__((aligned(16))) unsigned char lds_raw[];
    LAS unsigned char* lds = (LAS unsigned char*)lds_raw;
    volatile LAS unsigned* MISC = (volatile LAS unsigned*)(lds + MISC_OFF);
    const int G = gridDim.x, c = blockIdx.x;
    const GridPos gp{G, c};
    const long gthreads = (long)G * NTHREADS; const int gwaves = G * NWAVES;
#define TIDS() int tid = threadIdx.x; asm volatile("" : "+v"(tid)); const int lane = tid & 63, wave = __builtin_amdgcn_readfirstlane(tid >> 6); const long gtid = (long)c * NTHREADS + tid; const int gwave = c * NWAVES + wave; (void)lane; (void)gtid; (void)gwave
    for (int u = threadIdx.x; u < (LDS_BYTES - RING_BYTES) / 4; u += NTHREADS) ((LAS unsigned*)(lds + RING_BYTES))[u] = 0u;
    __syncthreads();
    unsigned* ctl = wsp<unsigned>(p, WS_CTL);
#if ONE_LAUNCH
    XcdBarrier bar = xcd_barrier_post(ctl + CW_BAR, MISC + 8);
#define GRID_BAR() xcd_barrier(bar)
#else
#define GRID_BAR() do { } while (0)
#endif
    const int lo = p.ph_lo, hi = p.ph_hi;
#define IN(k) (lo <= (k) && (k) < hi)
#define SEAM(k) do { if (IN(k) && IN((k) + 1)) GRID_BAR(); } while (0)

#define REPEAT(k, BODY) do { if constexpr (((PROBE_MASK) >> (k)) & 1u) { if (IN((k) >= 20 ? 9 : (k))) { GRID_BAR(); BODY } } } while (0)
#define PH0 { TIDS(); LAS float* scr = (LAS float*)(lds + wave * 8448); for (int it = gwave; it < TI_SMALL; it += gwaves) smallw_tile(p, it, scr, lane); \
        for (long it = gtid; it < IT_ROPE; it += gthreads) rope_tab_item(p, (int)it); for (long it = gtid; it < 64 * 64; it += gthreads) wr_frag_item(p, (int)it); \
        if (gtid == 0) { lambda_item(p); sbound_item(p); } for (int t = gwave * 4; t < NTOK; t += gwaves * 4) xn_rows4_wave(p, t, lane); }
    if (IN(0)) PH0; REPEAT(0, PH0); SEAM(0);
#if FP8_GATES
#define PH1 { { const ProbInProj pr = mk_inproj(p, gp); run_gemm(lds, pr, p.ws); } { const ProbInProjG pr = mk_inprojg(p, gp); run_gemm(lds, pr, p.ws); } }
#else
#define PH1 { const ProbInProj pr = mk_inproj(p, gp); run_gemm(lds, pr, p.ws); }
#endif
    if (IN(1)) PH1; REPEAT(1, PH1);
#if GEMM_EXPERIMENT >= 0
    if (IN(1)) { GRID_BAR(); ProbInProj pr = mk_inproj(p, gp); pr.P = wsp<bf16_t>(p, 960 * MiB) - (size_t)0; struct Dmy : ProbInProj { HD void epi(const Acc& acc, const Unit& u, int wr, int wc, int fr, int fq) const { Unit v = u; v.row0 = u.row0 & 255 ? 0 : 0; ProbInProj::epi(acc, v, wr, wc, fr, fq); } };
        Dmy dm; *(ProbInProj*)&dm = pr; if constexpr (GEMM_EXPERIMENT >= 20) pg8::gemm_phase_pipe2<Dmy, GEMM_EXPERIMENT - 20>(lds, dm, p.ws); else if constexpr (GEMM_EXPERIMENT >= 10) pg8::gemm_phase_pipe<Dmy, GEMM_EXPERIMENT - 10>(lds, dm, p.ws); else pg8::gemm_phase<Dmy, GEMM_EXPERIMENT < 10 ? GEMM_EXPERIMENT : 0>(lds, dm, p.ws); }
#endif
    SEAM(1);
#define PH2 { { const ProbUpQ pr = mk_upq(p, gp); run_gemm(lds, pr, p.ws); } { const ProbUpKV pr = mk_upkv(p, gp); run_gemm(lds, pr, p.ws); } }
    if (IN(2)) PH2; REPEAT(2, PH2); SEAM(2);
    if (IN(3)) { TIDS(); LAS float* buf = (LAS float*)(lds + wave * 8192);
        for (int t = gwave * 2; t < NTOK; t += gwaves * 2) post_tokens2_wave(p, t, lane, buf); }
    SEAM(3);
#if USE_MFMA_ATTN
#define PH4 { attn_mla_phase(lds, p, gp); }
#define PH5 { attn_diff_phase(lds, p, gp); }
#else
#define PH4 { }
#define PH5 { }
#endif
    if (IN(4)) PH4;
#if ATTN_EXPERIMENT >= 0
    if (IN(4)) { GRID_BAR(); int bh, qb;
        for (int i = 0; att::attn_next(gp, i, bh, qb); ++i) { const int b = bh >> 3, h = bh & 7; const size_t tok0 = (size_t)b * SEQ, row0 = tok0 + (size_t)qb * 256;
            att::attn_unit<96, 64, ATTN_EXPERIMENT>(lds, wsp<bf16_t>(p, WS_QA) + row0 * QA_W + h * 96, QA_W, wsp<bf16_t>(p, WS_KV) + tok0 * KV_W + h * 160, KV_W, wsp<bf16_t>(p, WS_KV) + tok0 * KV_W + h * 160 + 96, KV_W,
                                   wsp<bf16_t>(p, 960 * MiB) + (size_t)(c * 256) * 512 + h * 64, 512, qb * 256); } }
#endif
    if (IN(5)) PH5; SEAM(5);
#define PH7 { const ProbBranch pr = mk_branch(p, gp); run_gemm(lds, pr, p.ws); }
    if (IN(7)) PH7; REPEAT(7, PH7); SEAM(7);
#define PH8 { const ProbOut pr = mk_out(p, gp); run_gemm(lds, pr, p.ws); }
    if (IN(8)) PH8; REPEAT(8, PH8); SEAM(8);
#define PH9 { TIDS(); LAS float* lbuf = (LAS float*)(lds + wave * 4608); LAS int* cnts = (LAS int*)(lds + NWAVES * 4608); \
        for (int chunk = c; chunk < NCHUNK; chunk += G) { const int t0 = chunk * CHUNK; int idx[4], rank[4]; \
            router_wave2(p, t0 + wave * 32, wave, lane, lbuf, cnts, idx, rank); \
            __syncthreads(); \
            router_finish(p, t0 + wave * 32, chunk, wave, lane, cnts, idx, rank); \
            __syncthreads(); } }
#define PH9W { TIDS(); __syncthreads(); LAS float* scr = (LAS float*)(lds + wave * 8448); for (int it = gwave; it < TI_MOEW; it += gwaves) moew_tile(p, it, scr, lane); }
    if (IN(9)) { PH9; } REPEAT(9, PH9);
    SEAM(9);
#define PH10 { TIDS(); \
        LAS int* cc = (LAS int*)lds;                                   \
        LAS int* tot = cc + NCHUNK * 32;                               \
        LAS int* ebs = tot + 64; \
        const int* gcc = wsp<int>(p, WS_MISC + MS_CHUNKCNT); \
        for (int i = tid; i < NCHUNK * 32; i += NTHREADS) cc[i] = gcc[i]; \
        __syncthreads(); \
        if (tid < NHALF * 32) { const int hf = tid >> 5, e = tid & 31; int s = 0; for (int ch = hf * CHUNK_PER_HALF; ch < (hf + 1) * CHUNK_PER_HALF; ++ch) s += cc[ch * 32 + e]; tot[tid] = s; } \
        __syncthreads(); \
        if (tid < NHALF * 32) { const int hf = tid >> 5, e = tid & 31; int s = 0; for (int e2 = 0; e2 < e; ++e2) s += tot[hf * 32 + e2]; ebs[tid] = s; } \
        __syncthreads(); \
        if (c == 0 && tid < NHALF) {                                       \
            const int hf = tid; int* eb = wsp<int>(p, WS_MISC + MS_EBASE); int* nt = wsp<int>(p, WS_MISC + MS_NTILES); int* tl = wsp<int>(p, WS_MISC + MS_TILES); int n = 0; \
            for (int e = 0; e < NE; ++e) { const int cnt = tot[hf * 32 + e], run = ebs[hf * 32 + e]; eb[hf * 33 + e] = run; \
                for (int r = 0; r < cnt; r += 256) { int* t = tl + ((size_t)hf * MAX_TILES + n) * 4; t[0] = e; t[1] = run + r; t[2] = (cnt - r) < 256 ? (cnt - r) : 256; t[3] = 0; ++n; } } \
            nt[hf] = n; } \
        LAS int* pre = ebs + 64; \
        for (int chunk = c; chunk < NCHUNK; chunk += G) { const int hf = chunk / CHUNK_PER_HALF; \
            __syncthreads(); \
            if (tid < 32) { int s = ebs[hf * 32 + tid]; for (int ch = hf * CHUNK_PER_HALF; ch < chunk; ++ch) s += cc[ch * 32 + tid]; pre[tid] = s; } \
            __syncthreads(); \
            for (int it = tid; it < CHUNK * 4; it += NTHREADS) { const long item = (long)chunk * CHUNK * 4 + it; const int token = (int)(item >> 2); const int e = wsp<int>(p, WS_TOPI)[item]; \
                const int slot = pre[e] + wsp<int>(p, WS_SLOT)[item];            \
                wsp<int>(p, WS_SLOT)[item] = slot; wsp<int>(p, WS_TOKOF)[(size_t)hf * HALF_SLOTS + slot] = token; wsp<float>(p, WS_WOF)[(size_t)hf * HALF_SLOTS + slot] = wsp<float>(p, WS_TOPW)[item]; wsp<float>(p, WS_RSOF)[(size_t)hf * HALF_SLOTS + slot] = wsp<float>(p, WS_MISC + MS_RSTD)[token]; } } \
        __syncthreads(); \
        LAS float* scr = (LAS float*)(lds + wave * 8448); for (int it = gwave; it < TI_MOEW; it += gwaves) moew_tile(p, it, scr, lane); \
    }
    if (IN(10)) PH10; REPEAT(10, PH10);
    SEAM(10);
#define PH12 { const ProbMoe1 pr = mk_moe1(p, gp, 0); run_gemm(lds, pr, p.ws); }
#define PH13 { const ProbMoe2 pr = mk_moe2(p, gp, 0); run_gemm(lds, pr, p.ws); }
#if CFG_NHALF == 2
#define PH15 { const ProbMoe1 pr = mk_moe1(p, gp, 1); run_gemm(lds, pr, p.ws); }
#define PH16 { const ProbMoe2 pr = mk_moe2(p, gp, 1); run_gemm(lds, pr, p.ws); }
#endif
    if (IN(12)) PH12; REPEAT(12, PH12); SEAM(12);
    if (IN(13)) PH13; REPEAT(13, PH13); SEAM(13);
    if (IN(14)) { { TIDS(); for (long it = gtid; it < (long)HALF_TOK * 128; it += gthreads) final_item(p, 0, it); }
#if CFG_NHALF == 2
        PH15;
#endif
    }
#if CFG_NHALF == 2
    SEAM(14);
    if (IN(16)) PH16; REPEAT(16, PH16); SEAM(16);
    if (IN(17)) { TIDS(); for (long it = gtid; it < (long)HALF_TOK * 128; it += gthreads) final_item(p, 1, it); }
#endif
#undef IN
#undef SEAM
}

extern "C" void kernel_launch(void* const* d_in, const int* in_sizes, int n_in, void* d_out, int out_size, void* d_ws, size_t ws_size, hipStream_t stream) {
    static int grid = 0;
    if (grid == 0) {
        if (n_in != 26 || in_sizes[0] != NTOK * 1024 || out_size != NTOK * 1024 || ws_size < WS_END) {
            fprintf(stderr, "kernel_launch: unexpected shapes: n_in %d in0 %d out %d ws %zu (need %zu)\n", n_in, n_in > 0 ? in_sizes[0] : -1, out_size, ws_size, (size_t)WS_END); grid = -1; return; }
        int dev = 0, cus = 0;
        if (hipGetDevice(&dev) != hipSuccess || hipDeviceGetAttribute(&cus, hipDeviceAttributeMultiprocessorCount, dev) != hipSuccess) { grid = -1; return; }
        if (hipFuncSetAttribute((const void*)fwd, hipFuncAttributeMaxDynamicSharedMemorySize, LDS_BYTES) != hipSuccess) { fprintf(stderr, "kernel_launch: hipFuncSetAttribute failed\n"); grid = -1; return; }
        int per_cu = 0;
        if (hipOccupancyMaxActiveBlocksPerMultiprocessor(&per_cu, (const void*)fwd, NTHREADS, LDS_BYTES) != hipSuccess || per_cu < 1) fprintf(stderr, "kernel_launch: occupancy query reports %d\n", per_cu);
        (void)hipGetLastError();
        grid = cus;
    }
    if (grid < 0) return;
    (void)hipMemsetAsync((char*)d_ws + WS_CTL, 0, 1 * MiB, stream);
    Params p{};
    const float** f = (const float**)&p;
    for (int i = 0; i < 26; ++i) f[i] = (const float*)d_in[i];
    p.out = (float*)d_out; p.ws = (unsigned char*)d_ws;
#if ONE_LAUNCH
    p.ph_lo = 0; p.ph_hi = N_PHASES;
    hipLaunchKernelGGL(fwd, dim3(grid), dim3(NTHREADS), LDS_BYTES, stream, p);
#else
    for (int ph = 0; ph < 18; ++ph) {
        p.ph_lo = ph; p.ph_hi = ph + 1;
#if !USE_MFMA_GEMM
        if (ph == 1) { hipLaunchKernelGGL(ref_gemm_kernel<1>, dim3(grid), dim3(NTHREADS), 0, stream, p); continue; }
        if (ph == 2) { hipLaunchKernelGGL(ref_gemm_kernel<2>, dim3(grid), dim3(NTHREADS), 0, stream, p); hipLaunchKernelGGL(ref_gemm_kernel<3>, dim3(grid), dim3(NTHREADS), 0, stream, p); continue; }
        if (ph == 7) { hipLaunchKernelGGL(ref_gemm_kernel<7>, dim3(grid), dim3(NTHREADS), 0, stream, p); continue; }
        if (ph == 8) { hipLaunchKernelGGL(ref_gemm_kernel<8>, dim3(grid), dim3(NTHREADS), 0, stream, p); continue; }
        if (ph == 12) { hipLaunchKernelGGL(ref_gemm_kernel<12>, dim3(grid), dim3(NTHREADS), 0, stream, p); continue; }
        if (ph == 13) { hipLaunchKernelGGL(ref_gemm_kernel<13>, dim3(grid), dim3(NTHREADS), 0, stream, p); continue; }
        if (ph == 15) { hipLaunchKernelGGL(ref_gemm_kernel<15>, dim3(grid), dim3(NTHREADS), 0, stream, p); continue; }
        if (ph == 16) { hipLaunchKernelGGL(ref_gemm_kernel<16>, dim3(grid), dim3(NTHREADS), 0, stream, p); continue; }
#endif
#if !USE_MFMA_ATTN
        if (ph == 4) { hipLaunchKernelGGL(ref_attn_kernel<4>, dim3(grid * 8), dim3(256), 0, stream, p); continue; }
        if (ph == 5) { hipLaunchKernelGGL(ref_attn_kernel<5>, dim3(grid * 8), dim3(256), 0, stream, p); continue; }
#endif
        hipLaunchKernelGGL(fwd, dim3(grid), dim3(NTHREADS), LDS_BYTES, stream, p);
    }
#endif
}
```
